# Optimizing an MI355X kernel written in HIP

```python
import math
import jax, jax.numpy as jnp
from jax import lax
import numpy as np

D_MODEL = 2048
BATCH = 4
SEQ = 2048
DEPTH = 1
DEC_BATCH = 32
DEC_SEQ = 4
PAST_LEN = 16384
PAGE_SIZE = 128

M_HEADS = 4
M_WIDTH = D_MODEL
M_HEAD_DIM = M_WIDTH // M_HEADS
M_CHUNK = 64
A_HEADS = 32
A_HEAD_DIM = 64
A_KV_HEADS = 4
A_GROUP = A_HEADS // A_KV_HEADS
A_WIDTH = A_HEADS * A_HEAD_DIM
A_KV_WIDTH = A_KV_HEADS * A_HEAD_DIM
WINDOW = 128
DN_ALPHA = (2.0 * DEPTH) ** 0.25
DN_BETA = (8.0 * DEPTH) ** -0.25
LN_EPS = 1e-5

SPLITS = (M_WIDTH, M_WIDTH, M_WIDTH, M_WIDTH, M_WIDTH,
          A_WIDTH, A_KV_WIDTH, A_KV_WIDTH, A_WIDTH,
          D_MODEL, D_MODEL,
          M_HEADS, M_HEADS)
SPLIT_SCALES = (1.0, 1.0, DN_BETA, 1.0, 1.0,
                1.0, 1.0, DN_BETA, 1.0,
                1.0, 1.0,
                1.0, 1.0)
IN_COLS = sum(SPLITS)

kernel_name = 'hybrid_mlstm_swa_decode_step'


def _layernorm(x, w, b):
    xf = x.astype(jnp.float32)
    mu = jnp.mean(xf, axis=-1, keepdims=True)
    var = jnp.mean(jnp.square(xf - mu), axis=-1, keepdims=True)
    return (xf - mu) * lax.rsqrt(var + LN_EPS) * w.astype(jnp.float32) + b.astype(jnp.float32)


def _alibi_slopes():
    return 2.0 ** (-8.0 * jnp.arange(1, A_HEADS + 1, dtype=jnp.float32) / A_HEADS)


def _in_proj(x, w_in, b_igate, b_fgate):
    B, T, _ = x.shape
    u = jnp.einsum('btd,dc->btc', x, w_in)
    parts = []
    start = 0
    for width in SPLITS:
        parts.append(u[..., start:start + width])
        start += width
    q_m, k_m, v_m, o_m, z_m, q_a, k_a, v_a, z_a, g_m, g_a, i_pre, f_pre = parts
    mh = lambda a: a.reshape(B, T, M_HEADS, M_HEAD_DIM)
    ig = (i_pre + b_igate).astype(jnp.float32)
    lf = jax.nn.log_sigmoid((f_pre + b_fgate).astype(jnp.float32))
    return (mh(q_m), mh(k_m), mh(v_m), o_m, z_m,
            q_a.reshape(B, T, A_KV_HEADS, A_GROUP, A_HEAD_DIM),
            k_a.reshape(B, T, A_KV_HEADS, A_HEAD_DIM),
            v_a.reshape(B, T, A_KV_HEADS, A_HEAD_DIM),
            z_a, g_m, g_a, ig, lf)


def _mlstm_chunk(carry, inp):
    C, n, m = carry
    q, k, v, ig, lf = inp
    L = q.shape[2]
    b = jnp.cumsum(lf, axis=-1)
    causal = jnp.tril(jnp.ones((L, L), dtype=bool))
    log_d = jnp.where(causal, b[..., :, None] - b[..., None, :] + ig[..., None, :], -jnp.inf)
    log_inter = b + m[..., None]
    m_row = jnp.maximum(jnp.max(log_d, axis=-1), log_inter)
    d = jnp.exp(log_d - m_row[..., None])
    inter = jnp.exp(log_inter - m_row)
    s = jnp.einsum('bhtd,bhsd->bhts', q, k) * d
    num = jnp.einsum('bhts,bhsd->bhtd', s, v) + inter[..., None] * jnp.einsum('bhtk,bhkv->bhtv', q, C)
    den = jnp.sum(s, axis=-1) + inter * jnp.einsum('bhtk,bhk->bht', q, n)
    h = num / jnp.maximum(jnp.abs(den), jnp.exp(-m_row))[..., None]
    b_last = b[..., -1]
    log_w = b_last[..., None] - b + ig
    m_new = jnp.maximum(b_last + m, jnp.max(log_w, axis=-1))
    w = jnp.exp(log_w - m_new[..., None])
    decay = jnp.exp(b_last + m - m_new)
    C_new = decay[..., None, None] * C + jnp.einsum('bhsk,bhsv->bhkv', w[..., None] * k, v)
    n_new = decay[..., None] * n + jnp.einsum('bhs,bhsk->bhk', w, k)
    return (C_new, n_new, m_new), h


def _mlstm(q, k, v, ig, lf, C0, n0, m0):
    B, T = q.shape[:2]
    L = math.gcd(M_CHUNK, T)
    nc = T // L

    def to_chunks(a):
        a = a.astype(jnp.float32).reshape((B, nc, L) + a.shape[2:])
        return jnp.moveaxis(jnp.moveaxis(a, 1, 0), 3, 2)

    qc = to_chunks(q) * (M_HEAD_DIM ** -0.5)
    carry0 = (C0.astype(jnp.float32), n0.astype(jnp.float32), m0.astype(jnp.float32))
    (C, n, m), h = lax.scan(_mlstm_chunk, carry0,
                            (qc, to_chunks(k), to_chunks(v), to_chunks(ig), to_chunks(lf)))
    h = jnp.swapaxes(jnp.moveaxis(h, 0, 1), 2, 3).reshape(B, T, M_HEADS, M_HEAD_DIM)
    return h, C, n, m


def _sink_attend(q, k, v, dist, valid, slopes, sinks):
    s = jnp.einsum('...qhgd,...khd->...hgqk', q, k).astype(jnp.float32) * (A_HEAD_DIM ** -0.5)
    s = s - slopes.reshape(A_KV_HEADS, A_GROUP)[:, :, None, None] * dist[..., None, None, :, :].astype(jnp.float32)
    s = jnp.where(valid[..., None, None, :, :], s, -jnp.inf)
    sink = jnp.broadcast_to(sinks.astype(jnp.float32).reshape(A_KV_HEADS, A_GROUP)[:, :, None, None],
                            s.shape[:-1] + (1,))
    p = jax.nn.softmax(jnp.concatenate([s, sink], axis=-1), axis=-1)[..., :-1]
    return jnp.einsum('...hgqk,...khd->...qhgd', p.astype(v.dtype), v)


def _swa_prompt(q, k, v, slopes, sinks):
    B, S = q.shape[:2]
    nb = S // WINDOW
    qb = q.reshape(B, nb, WINDOW, A_KV_HEADS, A_GROUP, A_HEAD_DIM)
    kb = k.reshape(B, nb, WINDOW, A_KV_HEADS, A_HEAD_DIM)
    vb = v.reshape(B, nb, WINDOW, A_KV_HEADS, A_HEAD_DIM)
    pad = ((0, 0), (1, 0), (0, 0), (0, 0), (0, 0))
    kk = jnp.concatenate([jnp.pad(kb, pad)[:, :-1], kb], axis=2)
    vv = jnp.concatenate([jnp.pad(vb, pad)[:, :-1], vb], axis=2)
    qi = jnp.arange(WINDOW)[:, None]
    kj = jnp.arange(2 * WINDOW)[None, :]
    dist = qi + WINDOW - kj
    blk = jnp.arange(nb)[:, None, None]
    valid = (dist >= 0) & (dist < WINDOW) & ((blk > 0) | (kj >= WINDOW))
    out = _sink_attend(qb, kk, vv, dist, valid, slopes, sinks)
    return out.reshape(B, S, A_WIDTH)


def _swa_sample(q, k_new, v_new, k_buf, v_buf, slopes, sinks):
    B, T = q.shape[:2]
    Wb = k_buf.shape[1]
    k_all = jnp.concatenate([k_buf.astype(k_new.dtype), k_new], axis=1)
    v_all = jnp.concatenate([v_buf.astype(v_new.dtype), v_new], axis=1)
    qi = jnp.arange(T)[:, None]
    kj = jnp.arange(Wb + T)[None, :]
    dist = Wb + qi - kj
    valid = (dist >= 0) & (dist < WINDOW)
    out = _sink_attend(q, k_all, v_all, dist, valid, slopes, sinks)
    return out.reshape(B, T, A_WIDTH), k_all[:, T:], v_all[:, T:]


def _merge(x, h_m, o_m, z_m, h_a, z_a, g_m, g_a, mlstm_norm_w, w_proj_m, w_proj_a, w_out, ln_w, ln_b):
    B, T, _ = x.shape
    mu = jnp.mean(h_m, axis=-1, keepdims=True)
    var = jnp.mean(jnp.square(h_m - mu), axis=-1, keepdims=True)
    hn = (h_m - mu) * lax.rsqrt(var + LN_EPS) * mlstm_norm_w.astype(jnp.float32).reshape(M_HEADS, M_HEAD_DIM)
    br_m = hn.reshape(B, T, M_WIDTH) * jax.nn.sigmoid(o_m) * jax.nn.silu(z_m)
    br_a = h_a * jax.nn.silu(z_a)
    y = (jax.nn.sigmoid(g_m) * jnp.einsum('btc,cd->btd', br_m, w_proj_m)
         + jax.nn.sigmoid(g_a) * jnp.einsum('btc,cd->btd', br_a, w_proj_a))
    out = jnp.einsum('btc,cd->btd', y, w_out)
    return _layernorm(DN_ALPHA * x + out, ln_w, ln_b).astype(x.dtype)


def setup_inputs(seed: int = 0) -> dict:
    key = jax.random.key(seed)
    ks = jax.random.split(key, 18)
    f32 = jnp.float32
    wb = min(WINDOW, PAST_LEN)
    col_scale = jnp.concatenate([jnp.full((w,), s, f32) for w, s in zip(SPLITS, SPLIT_SCALES)])
    return {
        'x_prompt': jax.random.normal(ks[0], (BATCH, SEQ, D_MODEL), f32),
        'x_sample': jax.random.normal(ks[1], (DEC_BATCH, DEC_SEQ, D_MODEL), f32),
        'state_mlstm_C': jax.random.normal(ks[2], (DEC_BATCH, M_HEADS, M_HEAD_DIM, M_HEAD_DIM), f32),
        'state_mlstm_n': jax.random.normal(ks[3], (DEC_BATCH, M_HEADS, M_HEAD_DIM), f32),
        'state_mlstm_m': 0.5 * jax.random.normal(ks[4], (DEC_BATCH, M_HEADS), f32),
        'state_attn_k': jax.random.normal(ks[5], (DEC_BATCH, wb, A_KV_HEADS, A_HEAD_DIM), f32),
        'state_attn_v': 0.6 * jax.random.normal(ks[6], (DEC_BATCH, wb, A_KV_HEADS, A_HEAD_DIM), f32),
        'w_in': jax.random.normal(ks[7], (D_MODEL, IN_COLS), f32) * (D_MODEL ** -0.5) * col_scale,
        'b_igate': 0.1 * jax.random.normal(ks[8], (M_HEADS,), f32),
        'b_fgate': jnp.linspace(3.0, 6.0, M_HEADS, dtype=f32) + 0.1 * jax.random.normal(ks[9], (M_HEADS,), f32),
        'mlstm_norm_w': 1.0 + 0.1 * jax.random.normal(ks[10], (M_WIDTH,), f32),
        'attn_sinks': 0.5 * jax.random.normal(ks[11], (A_HEADS,), f32),
        'w_proj_m': jax.random.normal(ks[12], (M_WIDTH, D_MODEL), f32) * (M_WIDTH ** -0.5) * DN_BETA,
        'w_proj_a': jax.random.normal(ks[13], (A_WIDTH, D_MODEL), f32) * (A_WIDTH ** -0.5) * DN_BETA,
        'w_out': jax.random.normal(ks[14], (D_MODEL, D_MODEL), f32) * (D_MODEL ** -0.5) * DN_BETA,
        'ln_w': 1.0 + 0.1 * jax.random.normal(ks[15], (D_MODEL,), f32),
        'ln_b': 0.1 * jax.random.normal(ks[16], (D_MODEL,), f32),
    }


def reference(x_prompt, x_sample, state_mlstm_C, state_mlstm_n, state_mlstm_m, state_attn_k, state_attn_v,
              w_in, b_igate, b_fgate, mlstm_norm_w, attn_sinks, w_proj_m, w_proj_a, w_out, ln_w, ln_b):
    slopes = _alibi_slopes()

    y_p = x_prompt
    for _ in range(DEPTH):
        (q_m, k_m, v_m, o_m, z_m, q_a, k_a, v_a, z_a, g_m, g_a, ig, lf) = _in_proj(y_p, w_in, b_igate, b_fgate)
        Bp, Sp = y_p.shape[:2]
        C0 = jnp.zeros((Bp, M_HEADS, M_HEAD_DIM, M_HEAD_DIM), jnp.float32)
        n0 = jnp.zeros((Bp, M_HEADS, M_HEAD_DIM), jnp.float32)
        m0 = jnp.zeros((Bp, M_HEADS), jnp.float32)
        h_m, C_p, n_p, m_p = _mlstm(q_m, k_m, v_m, ig, lf, C0, n0, m0)
        h_a = _swa_prompt(q_a, k_a, v_a, slopes, attn_sinks)
        buf = min(WINDOW, Sp)
        k_buf_p = k_a[:, Sp - buf:]
        v_buf_p = v_a[:, Sp - buf:]
        y_p = _merge(y_p, h_m, o_m, z_m, h_a, z_a, g_m, g_a, mlstm_norm_w, w_proj_m, w_proj_a, w_out, ln_w, ln_b)

    y_s = x_sample
    for _ in range(DEPTH):
        (q_m, k_m, v_m, o_m, z_m, q_a, k_a, v_a, z_a, g_m, g_a, ig, lf) = _in_proj(y_s, w_in, b_igate, b_fgate)
        h_m, C_s, n_s, m_s = _mlstm(q_m, k_m, v_m, ig, lf, state_mlstm_C, state_mlstm_n, state_mlstm_m)
        h_a, k_buf_s, v_buf_s = _swa_sample(q_a, k_a, v_a, state_attn_k, state_attn_v, slopes, attn_sinks)
        y_s = _merge(y_s, h_m, o_m, z_m, h_a, z_a, g_m, g_a, mlstm_norm_w, w_proj_m, w_proj_a, w_out, ln_w, ln_b)

    return (y_p, y_s, C_p, n_p, m_p, k_buf_p, v_buf_p, C_s, n_s, m_s, k_buf_s, v_buf_s)
```

```cpp
#include <hip/hip_runtime.h>
#include <cstdio>
#include <cstdint>
#include <cmath>
#ifndef MK_N_LAUNCHES
#define MK_N_LAUNCHES 7
#endif
namespace pg8 {
#define PG8_LAS __attribute__((address_space(3)))
typedef unsigned short bf16_t;
typedef short bf16x8 __attribute__((ext_vector_type(8)));
typedef float f32x4 __attribute__((ext_vector_type(4)));
typedef unsigned u32x4 __attribute__((ext_vector_type(4)));
constexpr int BM = 256, BK = 64, HALF = 128, HTB = HALF * BK * 2  , STAGE_BYTES = 8 * HTB, NXCD = 8, WGM = 8;

__host__ __device__ __forceinline__ int lds_byte(int r, int c) { const int st = (r >> 4) * 2 + (c >> 5), rr = r & 15, cc = c & 31, ob = rr * 64 + cc * 2; return st * 1024 + (ob ^ (((ob >> 9) & 1) << 5)); }
__host__ __device__ __forceinline__ void stage_rc(int b, int& R, int& C) { const int st = b / 1024, sb = b % 1024, swz = sb ^ (((sb >> 9) & 1) << 5); R = (st >> 1) * 16 + swz / 64; C = (st & 1) * 32 + (swz % 64) / 2; }
__host__ __device__ __forceinline__ int perm32(int rho) { const int n = rho >> 4, i = rho & 15; return 8 * (i >> 2) + 4 * n + (i & 3); }

struct Unit { int pm, pn; };
struct Gemm { const bf16_t* A; const bf16_t* Bt; int M, N, K; };

struct StaticOrder {
    int nM, nN, nwg, G, c;
    __host__ __device__ void init(int M, int N, int G_, int c_) { nM = M / BM; nN = N / BM; nwg = nM * nN; G = G_; c = c_; }
    __host__ __device__ bool next(int i, Unit& u) const {
        const long L = (long)i * G + c; if (L >= nwg) return false;
        int wgid = (int)L; { const int q = nwg / NXCD, r = nwg % NXCD, xcd = wgid % NXCD, off = wgid / NXCD; wgid = (xcd < r ? xcd * (q + 1) : r * (q + 1) + (xcd - r) * q) + off; }
        const int nig = WGM * nN, gid = wgid / nig, fm = gid * WGM, gsz = (nM - fm) < WGM ? (nM - fm) : WGM;
        u.pm = fm + ((wgid % nig) % gsz); u.pn = (wgid % nig) / gsz; return true;
    }
    __device__ __forceinline__ void a_ready(const Unit&) const {}
    __device__ __forceinline__ void done(const Unit&) const {}
};

__device__ __forceinline__ unsigned cvt_pk_bf16(float lo, float hi) { unsigned r; asm volatile("v_cvt_pk_bf16_f32 %0, %1, %2" : "=v"(r) : "v"(lo), "v"(hi)); return r; }
typedef float f32x2 __attribute__((ext_vector_type(2)));
__device__ __forceinline__ f32x2 gelu_pk(f32x2 v) {
    const f32x2 av = __builtin_elementwise_abs(v), d = av * 0.2316418882f + 1.0f;
    f32x2 t; t.x = __builtin_amdgcn_rcpf(d.x); t.y = __builtin_amdgcn_rcpf(d.y);
    f32x2 q = t * 0.5307027145f + (-0.7265760135f); q = q * t + 0.7107068705f; q = q * t + (-0.142248368f); q = q * t + 0.127414796f; q = q * t;
    const f32x2 s = (v * v) * (-0.72134752044f);
    f32x2 e; e.x = __builtin_amdgcn_exp2f(s.x); e.y = __builtin_amdgcn_exp2f(s.y);
    const f32x2 m = v * (q * e), r = v - m;
    f32x2 o; o.x = v.x < 0.f ? m.x : r.x; o.y = v.y < 0.f ? m.y : r.y; return o;
}

template <int ACT  > struct EpiBf16 {
    static constexpr bool PERM = true, AFTER_DRAIN = false; static_assert(ACT == 0 || ACT == 1, "EpiBf16: ACT is 0 (none) or 1 (gelu_pk)");
    bf16_t* O; int ldc; const float* bias; int split_cols; size_t split_stride; float scale0;
    __device__ __forceinline__ void operator()(const f32x4 (&acc)[2][2][4][2], const Unit& u, int wr, int wc, int fr, int fq) const {
        const int row0 = u.pm * BM + wr * 64 + fr; int colt = u.pn * BM; bf16_t* base = O;
        float sc = 1.f; if (split_cols) { const int t = colt / split_cols; base += (size_t)t * split_stride; colt -= t * split_cols; if (t == 0) sc = scale0; }
        const int col0 = colt + wc * 32 + 8 * fq, bcol0 = u.pn * BM + wc * 32 + 8 * fq;
        f32x4 bv[2][2];
#pragma unroll
        for (int bj = 0; bj < 2; ++bj)
#pragma unroll
            for (int n = 0; n < 2; ++n) bv[bj][n] = bias ? *(const f32x4*)(bias + bcol0 + bj * HALF + 4 * n) : (f32x4){0.f, 0.f, 0.f, 0.f};
#pragma unroll
        for (int ai = 0; ai < 2; ++ai)
#pragma unroll
            for (int m = 0; m < 4; ++m) { bf16_t* rowp = base + (size_t)(row0 + ai * HALF + m * 16) * ldc + col0;
#pragma unroll
                for (int bj = 0; bj < 2; ++bj) { f32x4 v0 = acc[ai][bj][m][0] + bv[bj][0], v1 = acc[ai][bj][m][1] + bv[bj][1];
                    if (ACT == 1) { f32x2 a = gelu_pk((f32x2){v0[0], v0[1]}), b = gelu_pk((f32x2){v0[2], v0[3]}), c = gelu_pk((f32x2){v1[0], v1[1]}), d = gelu_pk((f32x2){v1[2], v1[3]});
                        v0 = (f32x4){a.x, a.y, b.x, b.y}; v1 = (f32x4){c.x, c.y, d.x, d.y}; }
                    v0 = v0 * sc; v1 = v1 * sc; u32x4 w; w.x = cvt_pk_bf16(v0[0], v0[1]); w.y = cvt_pk_bf16(v0[2], v0[3]); w.z = cvt_pk_bf16(v1[0], v1[1]); w.w = cvt_pk_bf16(v1[2], v1[3]);
                    *(u32x4*)(rowp + bj * HALF) = w; } }
    }
};

struct PanelStats {
    unsigned* xbuf;
    unsigned* cnt;
    unsigned* tmo;
    int ntn; float eps;
    unsigned code;
    __device__ __forceinline__ bool run(const f32x4 (&v)[2][2][4][2], const Unit& u, int wr, int wc, int fr, int fq, PG8_LAS unsigned char* lds, int wid, int lane) const {
        typedef float f32x2v __attribute__((ext_vector_type(2)));
        PG8_LAS f32x2v* P = (PG8_LAS f32x2v*)lds;
        PG8_LAS f32x2v* S = (PG8_LAS f32x2v*)(lds + 8192);
        PG8_LAS unsigned* flag = (PG8_LAS unsigned*)(lds + 8192 + 2048);
#pragma unroll
        for (int ai = 0; ai < 2; ++ai)
#pragma unroll
            for (int m = 0; m < 4; ++m) {
                float s = 0.f;
#pragma unroll
                for (int bj = 0; bj < 2; ++bj)
#pragma unroll
                    for (int n = 0; n < 2; ++n) { const f32x4 x = v[ai][bj][m][n]; s += (x[0] + x[1]) + (x[2] + x[3]); }
                s += __shfl_xor(s, 16); s += __shfl_xor(s, 32);
                const float mw = s * (1.0f / 64.0f); float q = 0.f;
#pragma unroll
                for (int bj = 0; bj < 2; ++bj)
#pragma unroll
                    for (int n = 0; n < 2; ++n) { const f32x4 d = v[ai][bj][m][n] - mw; q += (d[0] * d[0] + d[1] * d[1]) + (d[2] * d[2] + d[3] * d[3]); }
                q += __shfl_xor(q, 16); q += __shfl_xor(q, 32);
                if (fq == 0) P[(ai * HALF + wr * 64 + m * 16 + fr) * 4 + wc] = (f32x2v){mw, q};
            }
        asm volatile("s_waitcnt lgkmcnt(0)" ::: "memory"); __builtin_amdgcn_s_barrier(); asm volatile("" ::: "memory");
#if defined(BROKEN_EXCHANGE_NO_WAIT)
#warning BROKEN CONTROL BUILD: the row-statistics exchange does not wait; results are wrong by design
        if (blockIdx.x >= 64) { const long long t0_ = clock64(); while (clock64() - t0_ < 60000) __builtin_amdgcn_s_sleep(8); }
#endif
        const int row = wid * 32 + (lane & 31);
        if (lane < 32) {
            const f32x2v a = P[row * 4 + 0], b = P[row * 4 + 1], c = P[row * 4 + 2], d = P[row * 4 + 3];
            const float mt = (a.x + b.x + c.x + d.x) * 0.25f;
            const float da = a.x - mt, db = b.x - mt, dc = c.x - mt, dd = d.x - mt;
            const float m2 = (a.y + b.y) + (c.y + d.y) + 64.0f * ((da * da + db * db) + (dc * dc + dd * dd));
            unsigned long long* slot = (unsigned long long*)xbuf + ((size_t)(u.pm * BM + row) * 4 + u.pn);
            __hip_atomic_store(slot, ((unsigned long long)__float_as_uint(m2) << 32) | __float_as_uint(mt), __ATOMIC_RELAXED, __HIP_MEMORY_SCOPE_AGENT);
        }
        asm volatile("s_waitcnt vmcnt(0)" ::: "memory");
        if (lane == 0) __hip_atomic_fetch_add(cnt + 64 * u.pm, 1u, __ATOMIC_RELAXED, __HIP_MEMORY_SCOPE_AGENT);
        if (wid == 0) {
            bool dead = false; const unsigned long long t0 = __builtin_amdgcn_s_memrealtime(); const unsigned want = 8u * (unsigned)ntn;
            for (;;) {
#if defined(BROKEN_EXCHANGE_NO_WAIT)
                break;
#endif
                if ((unsigned)__builtin_amdgcn_readfirstlane(__hip_atomic_load(cnt + 64 * u.pm, __ATOMIC_RELAXED, __HIP_MEMORY_SCOPE_AGENT)) >= want) break;
                if (__builtin_amdgcn_s_memrealtime() - t0 > 2000000ull) {
                    if (lane == 0) { unsigned expect = 0u; __hip_atomic_compare_exchange_strong(tmo + 1, &expect, code | (unsigned)(u.pm & 0xff), __ATOMIC_RELAXED, __ATOMIC_RELAXED, __HIP_MEMORY_SCOPE_AGENT);
                                     __hip_atomic_store(tmo, 1u, __ATOMIC_RELAXED, __HIP_MEMORY_SCOPE_AGENT); }
                    dead = true; break; }
                __builtin_amdgcn_s_sleep(2);
            }
            __builtin_amdgcn_fence(__ATOMIC_ACQUIRE, "agent");
            if (lane == 0) flag[0] = dead ? 1u : 0u;
        }
        asm volatile("s_waitcnt vmcnt(0) lgkmcnt(0)" ::: "memory"); __builtin_amdgcn_s_barrier(); asm volatile("" ::: "memory");
        const bool bad = flag[0] != 0u;
        if (lane < 32) {
            const unsigned long long* slot = (const unsigned long long*)xbuf + (size_t)(u.pm * BM + row) * 4; float mt[4], m2[4]; float ms = 0.f;
#pragma unroll
            for (int t = 0; t < 4; ++t) { if (t < ntn) { const unsigned long long w = __hip_atomic_load(slot + t, __ATOMIC_RELAXED, __HIP_MEMORY_SCOPE_AGENT); mt[t] = __uint_as_float((unsigned)w); m2[t] = __uint_as_float((unsigned)(w >> 32)); } else { mt[t] = 0.f; m2[t] = 0.f; } ms += mt[t]; }
            const float mean = ms / (float)ntn; float q = 0.f;
#pragma unroll
            for (int t = 0; t < 4; ++t) if (t < ntn) { const float dm = mt[t] - mean; q += m2[t] + 256.0f * dm * dm; }
            S[row] = (f32x2v){mean, 1.0f / sqrtf(q / (256.0f * (float)ntn) + eps)};
        }
        asm volatile("s_waitcnt lgkmcnt(0)" ::: "memory"); __builtin_amdgcn_s_barrier(); asm volatile("" ::: "memory");
        return bad;
    }
};
struct EpiLnRes {
    static constexpr bool PERM = false, AFTER_DRAIN = true;
    const float* base; float* out; int ldc; const float* bias; PanelStats st; unsigned poison;
    __device__ __forceinline__ void fused(f32x4 (&acc)[2][2][4][2], const Unit& u, int wr, int wc, int fr, int fq, PG8_LAS unsigned char* lds, int wid, int lane) const {
        typedef float f32x2v __attribute__((ext_vector_type(2)));
        const PG8_LAS f32x2v* S = (const PG8_LAS f32x2v*)(lds + 8192);
        const int col0 = u.pn * BM + wc * 32 + 4 * fq;
#pragma unroll
        for (int bj = 0; bj < 2; ++bj)
#pragma unroll
            for (int n = 0; n < 2; ++n) { const f32x4 bv = bias ? *(const f32x4*)(bias + col0 + bj * HALF + n * 16) : (f32x4){0.f, 0.f, 0.f, 0.f};
#pragma unroll
                for (int ai = 0; ai < 2; ++ai)
#pragma unroll
                    for (int m = 0; m < 4; ++m) acc[ai][bj][m][n] += bv; }
        f32x4 pre[4][2][2];
#pragma unroll
        for (int m = 0; m < 4; ++m) { const size_t off = (size_t)(u.pm * BM + wr * 64 + m * 16 + fr) * ldc + col0;
#pragma unroll
            for (int bj = 0; bj < 2; ++bj)
#pragma unroll
                for (int n = 0; n < 2; ++n) pre[m][bj][n] = *(const f32x4*)(base + off + bj * HALF + n * 16); }
        const bool bad = st.run(acc, u, wr, wc, fr, fq, lds, wid, lane) || poison != 0u;
        const float qnan = __builtin_nanf("");
#pragma unroll
        for (int ai = 0; ai < 2; ++ai)
#pragma unroll
            for (int m = 0; m < 4; ++m) { const int r = ai * HALF + wr * 64 + m * 16 + fr; const f32x2v sr = S[r]; const size_t off = (size_t)(u.pm * BM + r) * ldc + col0;
#pragma unroll
                for (int bj = 0; bj < 2; ++bj)
#pragma unroll
                    for (int n = 0; n < 2; ++n) { const f32x4 bs = ai == 0 ? pre[m][bj][n] : *(const f32x4*)(base + off + bj * HALF + n * 16); f32x4 o = bs + (acc[ai][bj][m][n] - sr.x) * sr.y;
                        if (bad) o = (f32x4){qnan, qnan, qnan, qnan}; *(f32x4*)(out + off + bj * HALF + n * 16) = o; }
                if (m & 1) asm volatile("" ::: "memory"); }
    }
};
struct EpiLnResLn {
    static constexpr bool PERM = false, AFTER_DRAIN = true;
    const float* base; float* out; bf16_t* xn; int ldc; const float* bias; PanelStats st1, st2; unsigned poison;
    __device__ __forceinline__ void fused(f32x4 (&acc)[2][2][4][2], const Unit& u, int wr, int wc, int fr, int fq, PG8_LAS unsigned char* lds, int wid, int lane) const {
        typedef float f32x2v __attribute__((ext_vector_type(2))); typedef unsigned u32x2v __attribute__((ext_vector_type(2)));
        const PG8_LAS f32x2v* S = (const PG8_LAS f32x2v*)(lds + 8192);
        const int col0 = u.pn * BM + wc * 32 + 4 * fq;
#pragma unroll
        for (int bj = 0; bj < 2; ++bj)
#pragma unroll
            for (int n = 0; n < 2; ++n) { const f32x4 bv = bias ? *(const f32x4*)(bias + col0 + bj * HALF + n * 16) : (f32x4){0.f, 0.f, 0.f, 0.f};
#pragma unroll
                for (int ai = 0; ai < 2; ++ai)
#pragma unroll
                    for (int m = 0; m < 4; ++m) acc[ai][bj][m][n] += bv; }
        bool bad = st1.run(acc, u, wr, wc, fr, fq, lds, wid, lane) || poison != 0u;
        const float qnan = __builtin_nanf("");
#pragma unroll
        for (int ai = 0; ai < 2; ++ai)
#pragma unroll
            for (int m = 0; m < 4; ++m) { const int r = ai * HALF + wr * 64 + m * 16 + fr; const f32x2v sr = S[r]; const size_t off = (size_t)(u.pm * BM + r) * ldc + col0;
#pragma unroll
                for (int bj = 0; bj < 2; ++bj)
#pragma unroll
                    for (int n = 0; n < 2; ++n) { const f32x4 bs = *(const f32x4*)(base + off + bj * HALF + n * 16); acc[ai][bj][m][n] = bs + (acc[ai][bj][m][n] - sr.x) * sr.y; }
                asm volatile("" : "+v"(acc[ai][0][m][0]), "+v"(acc[ai][0][m][1]), "+v"(acc[ai][1][m][0]), "+v"(acc[ai][1][m][1]));
                if (m & 1) asm volatile("" ::: "memory"); }
        const bool bad1 = bad;
        bad = st2.run(acc, u, wr, wc, fr, fq, lds, wid, lane) || bad;
#pragma unroll
        for (int ai = 0; ai < 2; ++ai)
#pragma unroll
            for (int m = 0; m < 4; ++m) { const int r = ai * HALF + wr * 64 + m * 16 + fr; const f32x2v sr = S[r]; const size_t off = (size_t)(u.pm * BM + r) * ldc + col0;
#pragma unroll
                for (int bj = 0; bj < 2; ++bj)
#pragma unroll
                    for (int n = 0; n < 2; ++n) { const f32x4 x1 = acc[ai][bj][m][n]; *(f32x4*)(out + off + bj * HALF + n * 16) = bad1 ? (f32x4){qnan, qnan, qnan, qnan} : x1;
                        const f32x4 o = (x1 - sr.x) * sr.y; u32x2v w; w.x = cvt_pk_bf16(o[0], o[1]); w.y = cvt_pk_bf16(o[2], o[3]);
                        if (bad) { w.x = 0x7fc07fc0u; w.y = 0x7fc07fc0u; } *(u32x2v*)(xn + off + bj * HALF + n * 16) = w; }
                asm volatile("" ::: "memory"); }
    }
};

template <class Epi, class Sched, bool ALIGN_EPI = false, bool SP2 = false>
__device__ __forceinline__ void gemm_phase(PG8_LAS unsigned char* lds, const Gemm g, const Sched& S, const Epi& E) {
    const int tid = threadIdx.x, wid = __builtin_amdgcn_readfirstlane(tid >> 6), lane = tid & 63, wr = wid >> 2, wc = wid & 3, fr = lane & 15, fq = lane >> 4;
    const int K = g.K, nt = K / BK;
    unsigned voffA[2], voffB[2];
#pragma unroll
    for (int i = 0; i < 2; ++i) { int R, C; stage_rc(tid * 16 + i * 8192, R, C); const int Rb = Epi::PERM ? ((R & ~31) + perm32(R & 31)) : R;
        voffA[i] = (unsigned)(R * K + C) * 2u; voffB[i] = (unsigned)(Rb * K + C) * 2u; }
    const size_t kstep = (size_t)(BK * 2);
    const size_t hstep = (size_t)HALF * K * 2;
    const size_t tstep = 2 * hstep;
    const unsigned ldsw = (unsigned)wid * 1024u;
    const int aoff = lds_byte(wr * 64 + fr, fq * 8), boff = lds_byte(wc * 32 + fr, fq * 8);
#define PG8_SA(b, h) (((b) * 2 + (h)) * HTB)
#define PG8_SB(b, h) ((4 + (b) * 2 + (h)) * HTB)
#define PG8_STAGE(bufoff, gbase, voff) do { _Pragma("unroll") for (int _i = 0; _i < 2; ++_i) \
        __builtin_amdgcn_global_load_lds((const unsigned*)((const char*)(gbase) + (voff)[_i]), (PG8_LAS unsigned*)(lds + (bufoff) + ldsw + _i * 8192), 16, 0, 0); } while (0)
#define PG8_LDA(dst, b, h) do { _Pragma("unroll") for (int m = 0; m < 4; ++m) _Pragma("unroll") for (int k = 0; k < 2; ++k) dst[m][k] = *(const PG8_LAS bf16x8*)(lds + PG8_SA(b, h) + aoff + m * 2048 + k * 1024); } while (0)
#define PG8_LDB(dst, b, h) do { _Pragma("unroll") for (int n = 0; n < 2; ++n) _Pragma("unroll") for (int k = 0; k < 2; ++k) dst[n][k] = *(const PG8_LAS bf16x8*)(lds + PG8_SB(b, h) + boff + n * 2048 + k * 1024); } while (0)
#define PG8_MMA(ai, bj, At, Bt) do { __builtin_amdgcn_s_setprio(1); _Pragma("unroll") for (int m = 0; m < 4; ++m) _Pragma("unroll") for (int n = 0; n < 2; ++n) _Pragma("unroll") for (int k = 0; k < 2; ++k) \
        acc[ai][bj][m][n] = __builtin_amdgcn_mfma_f32_16x16x32_bf16(Bt[n][k], At[m][k], acc[ai][bj][m][n], 0, 0, 0); __builtin_amdgcn_s_setprio(0); } while (0)
#define PG8_WAIT_V(n) asm volatile("s_waitcnt vmcnt(" #n ")" ::: "memory")
#define PG8_WAIT_L(n) asm volatile("s_waitcnt lgkmcnt(" #n ")" ::: "memory")
#define PG8_BAR __builtin_amdgcn_s_barrier()
#define PG8_SCHED __builtin_amdgcn_sched_barrier(0)
    Unit cur, nxt; int ui = 0;
    if (!S.next(0, cur)) return;
    f32x4 acc[2][2][4][2];
#pragma unroll
    for (int a = 0; a < 2; ++a)
#pragma unroll
        for (int b = 0; b < 2; ++b)
#pragma unroll
            for (int m = 0; m < 4; ++m)
#pragma unroll
                for (int n = 0; n < 2; ++n) acc[a][b][m][n] = (f32x4){0.f, 0.f, 0.f, 0.f};
    bf16x8 At[4][2], B0[2][2], B1[2][2];
    const char* cA = (const char*)g.A + (size_t)cur.pm * tstep; const char* cB = (const char*)g.Bt + (size_t)cur.pn * tstep;
    S.a_ready(cur);
    if constexpr (SP2) {
        PG8_STAGE(PG8_SB(0, 0), cB, voffB); PG8_STAGE(PG8_SB(0, 1), cB + hstep, voffB); PG8_STAGE(PG8_SA(0, 0), cA, voffA); PG8_STAGE(PG8_SA(0, 1), cA + hstep, voffA);
        if (wr == 1) PG8_BAR;
        PG8_WAIT_V(2); PG8_BAR;
        PG8_STAGE(PG8_SB(1, 0), cB + kstep, voffB); PG8_STAGE(PG8_SA(1, 0), cA + kstep, voffA); PG8_STAGE(PG8_SB(1, 1), cB + hstep + kstep, voffB);
        PG8_WAIT_V(6); PG8_BAR;
    } else {
        PG8_STAGE(PG8_SB(0, 0), cB, voffB); PG8_STAGE(PG8_SA(0, 0), cA, voffA); PG8_STAGE(PG8_SB(0, 1), cB + hstep, voffB); PG8_STAGE(PG8_SA(0, 1), cA + hstep, voffA);
        if (wr == 1) PG8_BAR;
        PG8_WAIT_V(4); PG8_BAR;
        PG8_STAGE(PG8_SB(1, 0), cB + kstep, voffB); PG8_STAGE(PG8_SA(1, 0), cA + kstep, voffA); PG8_STAGE(PG8_SB(1, 1), cB + hstep + kstep, voffB);
        PG8_WAIT_V(6); PG8_BAR;
    }
    for (;;) {
        const bool has_next = S.next(ui + 1, nxt);
        const char* nA = has_next ? (const char*)g.A + (size_t)nxt.pm * tstep : cA; const char* nB = has_next ? (const char*)g.Bt + (size_t)nxt.pn * tstep : cB;
        for (int t = 0; t < nt; t += 2) {
            const bool last = (t == nt - 2);
            const char* a1 = cA + (size_t)(t + 1) * kstep;
            const char* a2 = last ? nA : cA + (size_t)(t + 2) * kstep; const char* b2 = last ? nB : cB + (size_t)(t + 2) * kstep;
            const char* a3 = a2 + kstep; const char* b3 = b2 + kstep;
            if (last && has_next) S.a_ready(nxt);
            if constexpr (SP2) {
            PG8_LDB(B0, 0, 0); PG8_LDB(B1, 0, 1); PG8_SCHED; PG8_LDA(At, 0, 0); PG8_STAGE(PG8_SA(1, 1), a1 + hstep, voffA);
            PG8_WAIT_V(8); PG8_WAIT_L(0); PG8_BAR; PG8_MMA(0, 0, At, B0); PG8_MMA(0, 1, At, B1); PG8_BAR; PG8_SCHED;
            PG8_LDA(At, 0, 1); PG8_STAGE(PG8_SB(0, 0), b2, voffB); PG8_STAGE(PG8_SB(0, 1), b2 + hstep, voffB); PG8_STAGE(PG8_SA(0, 0), a2, voffA);
            PG8_WAIT_V(8); PG8_WAIT_L(0); PG8_BAR; PG8_MMA(1, 0, At, B0); PG8_MMA(1, 1, At, B1); PG8_BAR; PG8_SCHED;
            PG8_LDB(B0, 1, 0); PG8_LDB(B1, 1, 1); PG8_SCHED; PG8_LDA(At, 1, 0); PG8_STAGE(PG8_SA(0, 1), a2 + hstep, voffA);
            PG8_WAIT_V(8); PG8_WAIT_L(0); PG8_BAR; PG8_MMA(0, 0, At, B0); PG8_MMA(0, 1, At, B1); PG8_BAR; PG8_SCHED;
            PG8_LDA(At, 1, 1); PG8_STAGE(PG8_SB(1, 0), b3, voffB); PG8_STAGE(PG8_SB(1, 1), b3 + hstep, voffB); PG8_STAGE(PG8_SA(1, 0), a3, voffA);
            PG8_WAIT_V(8); PG8_WAIT_L(0); PG8_BAR; PG8_MMA(1, 0, At, B0); PG8_MMA(1, 1, At, B1); PG8_BAR; PG8_SCHED;
            } else {
            PG8_LDB(B0, 0, 0); PG8_SCHED; PG8_LDA(At, 0, 0); PG8_STAGE(PG8_SA(1, 1), a1 + hstep, voffA);
            PG8_WAIT_L(8); PG8_BAR; PG8_WAIT_L(0); PG8_MMA(0, 0, At, B0); PG8_BAR; PG8_SCHED;
            PG8_LDB(B1, 0, 1); PG8_STAGE(PG8_SB(0, 0), b2, voffB);
            PG8_BAR; PG8_WAIT_L(0); PG8_MMA(0, 1, At, B1); PG8_BAR;
            PG8_LDA(At, 0, 1); PG8_STAGE(PG8_SA(0, 0), a2, voffA);
            PG8_BAR; PG8_WAIT_L(0); PG8_MMA(1, 0, At, B0); PG8_BAR; PG8_SCHED;
            PG8_STAGE(PG8_SB(0, 1), b2 + hstep, voffB);
            PG8_WAIT_V(6); PG8_BAR; PG8_MMA(1, 1, At, B1); PG8_BAR;
            PG8_LDB(B0, 1, 0); PG8_SCHED; PG8_LDA(At, 1, 0); PG8_STAGE(PG8_SA(0, 1), a2 + hstep, voffA);
            PG8_WAIT_L(8); PG8_BAR; PG8_WAIT_L(0); PG8_MMA(0, 0, At, B0); PG8_BAR; PG8_SCHED;
            PG8_LDB(B1, 1, 1); PG8_STAGE(PG8_SB(1, 0), b3, voffB);
            PG8_BAR; PG8_WAIT_L(0); PG8_MMA(0, 1, At, B1); PG8_BAR;
            PG8_LDA(At, 1, 1); PG8_STAGE(PG8_SA(1, 0), a3, voffA);
            PG8_BAR; PG8_WAIT_L(0); PG8_MMA(1, 0, At, B0); PG8_BAR; PG8_SCHED;
            PG8_STAGE(PG8_SB(1, 1), b3 + hstep, voffB);
            PG8_WAIT_V(6); PG8_BAR; PG8_MMA(1, 1, At, B1); PG8_BAR;
            }
        }
        if constexpr (ALIGN_EPI) { if (wr == 0) PG8_BAR; }
        if constexpr (!Epi::AFTER_DRAIN) { E(acc, cur, wr, wc, fr, fq); S.done(cur); }
        if (!has_next) break;
#pragma unroll
        for (int a = 0; a < 2; ++a)
#pragma unroll
            for (int b = 0; b < 2; ++b)
#pragma unroll
                for (int m = 0; m < 4; ++m)
#pragma unroll
                    for (int n = 0; n < 2; ++n) acc[a][b][m][n] = (f32x4){0.f, 0.f, 0.f, 0.f};
        cur = nxt; cA = nA; cB = nB; ++ui;
        if constexpr (ALIGN_EPI) { if (wr == 1) PG8_BAR; }
    }
    PG8_WAIT_V(0);
    if constexpr (!ALIGN_EPI) { if (wr == 0) PG8_BAR; }
    PG8_BAR;
    if constexpr (Epi::AFTER_DRAIN) { E.fused(acc, cur, wr, wc, fr, fq, lds, wid, lane); S.done(cur); }
#undef PG8_SA
#undef PG8_SB
#undef PG8_STAGE
#undef PG8_LDA
#undef PG8_LDB
#undef PG8_MMA
#undef PG8_WAIT_V
#undef PG8_WAIT_L
#undef PG8_BAR
#undef PG8_SCHED
}
}
namespace pg8 {
constexpr size_t EO_MiB = 1u << 20;
constexpr size_t EO_QM = 133 * EO_MiB, EO_KM = 166 * EO_MiB, EO_VM = 199 * EO_MiB, EO_GM = 232 * EO_MiB, EO_QA = 265 * EO_MiB, EO_SZA = 298 * EO_MiB, EO_SGM = 331 * EO_MiB, EO_SGA = 364 * EO_MiB, EO_KA = 397 * EO_MiB, EO_VA = 402 * EO_MiB;
constexpr size_t EO_KBP = 21241872, EO_VBP = 21372944, EO_KBS = 55124112, EO_VBS = 56172688;
__device__ __forceinline__ float sigmoid_f(float x) { return __builtin_amdgcn_rcpf(1.0f + __builtin_amdgcn_exp2f(-1.4426950408889634f * x)); }
__device__ __forceinline__ float bf_lo(unsigned w) { return __uint_as_float(w << 16); }
__device__ __forceinline__ float bf_hi(unsigned w) { return __uint_as_float(w & 0xffff0000u); }
struct EpiInProj {
    static constexpr bool PERM = true, AFTER_DRAIN = false;
    unsigned char* ws; float* out;
    __device__ __forceinline__ void operator()(const f32x4 (&acc)[2][2][4][2], const Unit& u, int wr, int wc, int fr, int fq) const {
        const int pn = u.pn, row0 = u.pm * BM + wr * 64 + fr, cl = wc * 32 + 8 * fq;
        if (pn >= 24 && pn < 40) {
            bf16_t* base = (bf16_t*)(ws + EO_GM) + (pn - 24) * 128 + cl;
#pragma unroll
            for (int ai = 0; ai < 2; ++ai)
#pragma unroll
                for (int m = 0; m < 4; ++m) {
                    const f32x4 o0 = acc[ai][0][m][0], o1 = acc[ai][0][m][1], z0 = acc[ai][1][m][0], z1 = acc[ai][1][m][1];
                    float g[8];
#pragma unroll
                    for (int e = 0; e < 4; ++e) { g[e] = sigmoid_f(o0[e]) * z0[e] * sigmoid_f(z0[e]); g[4 + e] = sigmoid_f(o1[e]) * z1[e] * sigmoid_f(z1[e]); }
                    u32x4 w; w.x = cvt_pk_bf16(g[0], g[1]); w.y = cvt_pk_bf16(g[2], g[3]); w.z = cvt_pk_bf16(g[4], g[5]); w.w = cvt_pk_bf16(g[6], g[7]);
                    *(u32x4*)(base + (size_t)(row0 + ai * HALF + m * 16) * 2048) = w;
                }
            return;
        }
        size_t doff; int ld = 2048, colt, mode = 0; float sc = 1.f;
        if (pn < 8) { doff = EO_QM; colt = pn * 256; sc = 0.04419417382415922f; }
        else if (pn < 16) { doff = EO_KM; colt = (pn - 8) * 256; }
        else if (pn < 24) { doff = EO_VM; colt = (pn - 16) * 256; }
        else if (pn < 48) { doff = EO_QA; colt = (pn - 40) * 256; sc = 0.125f; }
        else if (pn == 48) { doff = EO_KA; colt = 0; ld = 256; }
        else if (pn == 49) { doff = EO_VA; colt = 0; ld = 256; }
        else if (pn < 58) { doff = EO_SZA; colt = (pn - 50) * 256; mode = 1; }
        else if (pn < 66) { doff = EO_SGM; colt = (pn - 58) * 256; mode = 2; }
        else { doff = EO_SGA; colt = (pn - 66) * 256; mode = 2; }
#pragma unroll
        for (int ai = 0; ai < 2; ++ai)
#pragma unroll
            for (int m = 0; m < 4; ++m) {
                const int row = row0 + ai * HALF + m * 16;
#pragma unroll
                for (int bj = 0; bj < 2; ++bj) {
                    f32x4 v0 = acc[ai][bj][m][0] * sc, v1 = acc[ai][bj][m][1] * sc;
                    if (mode == 1) {
#pragma unroll
                        for (int e = 0; e < 4; ++e) { v0[e] = v0[e] * sigmoid_f(v0[e]); v1[e] = v1[e] * sigmoid_f(v1[e]); }
                    } else if (mode == 2) {
#pragma unroll
                        for (int e = 0; e < 4; ++e) { v0[e] = sigmoid_f(v0[e]); v1[e] = sigmoid_f(v1[e]); }
                    }
                    u32x4 w; w.x = cvt_pk_bf16(v0[0], v0[1]); w.y = cvt_pk_bf16(v0[2], v0[3]); w.z = cvt_pk_bf16(v1[0], v1[1]); w.w = cvt_pk_bf16(v1[2], v1[3]);
                    const int col = colt + bj * HALF + cl;
                    *(u32x4*)((bf16_t*)(ws + doff) + (size_t)row * ld + col) = w;
                    if (pn == 48 || pn == 49) {
                        float* o = nullptr;
                        if (row < 8192) { const int t = row & 2047; if (t >= 1920) o = (out + (pn == 48 ? EO_KBP : EO_VBP)) + ((size_t)((row >> 11) * 128 + (t - 1920)) * 256 + col); }
                        else if (row < 8320) { const int sr = row - 8192; o = (out + (pn == 48 ? EO_KBS : EO_VBS)) + ((size_t)((sr >> 2) * 128 + 124 + (sr & 3)) * 256 + col); }
                        if (o) { *(f32x4*)o = v0; *(f32x4*)(o + 4) = v1; }
                    }
                }
            }
    }
};
struct EpiPA {
    static constexpr bool PERM = true, AFTER_DRAIN = false;
    const bf16_t* SG; float* P;
    __device__ __forceinline__ void operator()(const f32x4 (&acc)[2][2][4][2], const Unit& u, int wr, int wc, int fr, int fq) const {
        const int row0 = u.pm * BM + wr * 64 + fr, col0 = u.pn * BM + wc * 32 + 8 * fq;
#pragma unroll
        for (int ai = 0; ai < 2; ++ai)
#pragma unroll
            for (int m = 0; m < 4; ++m)
#pragma unroll
                for (int bj = 0; bj < 2; ++bj) {
                    const size_t off = (size_t)(row0 + ai * HALF + m * 16) * 2048 + col0 + bj * HALF;
                    const u32x4 g = *(const u32x4*)(SG + off);
                    f32x4 v0 = acc[ai][bj][m][0], v1 = acc[ai][bj][m][1];
                    v0[0] *= bf_lo(g.x); v0[1] *= bf_hi(g.x); v0[2] *= bf_lo(g.y); v0[3] *= bf_hi(g.y);
                    v1[0] *= bf_lo(g.z); v1[1] *= bf_hi(g.z); v1[2] *= bf_lo(g.w); v1[3] *= bf_hi(g.w);
                    *(f32x4*)(P + off) = v0; *(f32x4*)(P + off + 4) = v1;
                }
    }
};
struct EpiY {
    static constexpr bool PERM = true, AFTER_DRAIN = false;
    const bf16_t* SG; const float* P; bf16_t* Y;
    __device__ __forceinline__ void operator()(const f32x4 (&acc)[2][2][4][2], const Unit& u, int wr, int wc, int fr, int fq) const {
        const int row0 = u.pm * BM + wr * 64 + fr, col0 = u.pn * BM + wc * 32 + 8 * fq;
#pragma unroll
        for (int ai = 0; ai < 2; ++ai)
#pragma unroll
            for (int m = 0; m < 4; ++m)
#pragma unroll
                for (int bj = 0; bj < 2; ++bj) {
                    const size_t off = (size_t)(row0 + ai * HALF + m * 16) * 2048 + col0 + bj * HALF;
                    const u32x4 g = *(const u32x4*)(SG + off);
                    const f32x4 p0 = *(const f32x4*)(P + off), p1 = *(const f32x4*)(P + off + 4);
                    f32x4 v0 = acc[ai][bj][m][0], v1 = acc[ai][bj][m][1];
                    v0[0] = v0[0] * bf_lo(g.x) + p0[0]; v0[1] = v0[1] * bf_hi(g.x) + p0[1]; v0[2] = v0[2] * bf_lo(g.y) + p0[2]; v0[3] = v0[3] * bf_hi(g.y) + p0[3];
                    v1[0] = v1[0] * bf_lo(g.z) + p1[0]; v1[1] = v1[1] * bf_hi(g.z) + p1[1]; v1[2] = v1[2] * bf_lo(g.w) + p1[2]; v1[3] = v1[3] * bf_hi(g.w) + p1[3];
                    u32x4 w; w.x = cvt_pk_bf16(v0[0], v0[1]); w.y = cvt_pk_bf16(v0[2], v0[3]); w.z = cvt_pk_bf16(v1[0], v1[1]); w.w = cvt_pk_bf16(v1[2], v1[3]);
                    *(u32x4*)(Y + off) = w;
                }
    }
};
struct EpiOut {
    static constexpr bool PERM = true, AFTER_DRAIN = false;
    const float* xp; const float* xs; float* out; float alpha;
    __device__ __forceinline__ void operator()(const f32x4 (&acc)[2][2][4][2], const Unit& u, int wr, int wc, int fr, int fq) const {
        const int row0 = u.pm * BM + wr * 64 + fr, col0 = u.pn * BM + wc * 32 + 8 * fq;
#pragma unroll
        for (int ai = 0; ai < 2; ++ai)
#pragma unroll
            for (int m = 0; m < 4; ++m) {
                const int row = row0 + ai * HALF + m * 16;
                if (row < 8320) {
                    const float* xr = row < 8192 ? xp + (size_t)row * 2048 : xs + (size_t)(row - 8192) * 2048;
#pragma unroll
                    for (int bj = 0; bj < 2; ++bj) {
                        const int col = col0 + bj * HALF;
                        const f32x4 x0 = *(const f32x4*)(xr + col), x1 = *(const f32x4*)(xr + col + 4);
                        *(f32x4*)(out + (size_t)row * 2048 + col) = x0 * alpha + acc[ai][bj][m][0];
                        *(f32x4*)(out + (size_t)row * 2048 + col + 4) = x1 * alpha + acc[ai][bj][m][1];
                    }
                }
            }
    }
};
}
#define GAS __attribute__((address_space(1)))
#define LAS __attribute__((address_space(3)))
typedef unsigned short bf16;
typedef unsigned v4u __attribute__((ext_vector_type(4)));
typedef float f32x4 __attribute__((ext_vector_type(4)));
typedef short bf16x8 __attribute__((ext_vector_type(8)));
typedef GAS unsigned gu32;
typedef GAS unsigned long long gu64;
#define RLX_AGENT __ATOMIC_RELAXED, __HIP_MEMORY_SCOPE_AGENT
#define LDS_WAIT() asm volatile("s_waitcnt lgkmcnt(0)" ::: "memory")
#define VM_WAIT() asm volatile("s_waitcnt vmcnt(0)" ::: "memory")
__device__ __forceinline__ unsigned long long rt() { return __builtin_amdgcn_s_memrealtime(); }
__device__ __forceinline__ unsigned f2bf(float f) { unsigned u = __builtin_bit_cast(unsigned, f); return (u + 0x7fffu + ((u >> 16) & 1u)) >> 16; }
__device__ __forceinline__ unsigned pk2(float lo, float hi) { return f2bf(lo) | (f2bf(hi) << 16); }

#define XB_TMO      128
#define XB_XCNT(j)  (256  + 64 * (j))
#define XB_XSUB(j)  (1280 + 64 * (j))
#define XB_XGEN(j)  (2304 + 64 * (j))
#define XB_TOP      3328
#define XB_TOPGEN   3392
#define XCD_BAR_WORDS 3456
#define XB_SPIN_CAP (1u << 18)

__device__ __forceinline__ unsigned xb_ld(unsigned* p)              { return __hip_atomic_load(p, __ATOMIC_RELAXED, __HIP_MEMORY_SCOPE_AGENT); }
__device__ __forceinline__ unsigned xb_add(unsigned* p, unsigned v) { return __hip_atomic_fetch_add(p, v, __ATOMIC_RELAXED, __HIP_MEMORY_SCOPE_AGENT); }
__device__ __forceinline__ unsigned xb_xcc_id() { return (unsigned)__builtin_amdgcn_s_getreg((3 << 11) | 20) & 0xFu; }
#define XB_SPIN(cond, bar) do { unsigned _sp = 0; while (cond) { __builtin_amdgcn_s_sleep(1); \
    if ((++_sp & 255u) == 0u) { if (xb_ld(&(bar)[XB_TMO])) break; if (_sp > XB_SPIN_CAP) { atomicAdd(&(bar)[XB_TMO], 1u); break; } } } } while (0)

struct XcdBarrier {
    unsigned* bar; unsigned x;
    volatile LAS unsigned* st;
};

__device__ __forceinline__ XcdBarrier xcd_barrier_post(unsigned* bar, volatile LAS unsigned* st) {
    XcdBarrier b; b.bar = bar; b.x = xb_xcc_id(); b.st = st;
    if (threadIdx.x == 0) (void)xb_add(&bar[XB_XCNT(b.x)], 1u);
    return b;
}
__device__ __forceinline__ void xcd_barrier_complete(unsigned* bar, unsigned x, unsigned& nloc, unsigned& nx) {
    const unsigned G = gridDim.x * gridDim.y * gridDim.z;
    unsigned sum, cnt, mine, sp = 0u;
    for (;;) {
        sum = 0u; cnt = 0u; mine = 0u;
#pragma unroll
        for (unsigned j = 0; j < 16; ++j) { const unsigned c = xb_ld(&bar[XB_XCNT(j)]); sum += c; cnt += (c > 0u) ? 1u : 0u; mine = (j == x) ? c : mine; }
        if (sum == G) break;
        __builtin_amdgcn_s_sleep(1);
        if ((++sp & 255u) == 0u) { if (xb_ld(&bar[XB_TMO])) break; if (sp > XB_SPIN_CAP) { atomicAdd(&bar[XB_TMO], 1u); break; } }
    }
    nloc = mine > 0u ? mine : 1u; nx = cnt > 0u ? cnt : 1u;
}

__device__ __forceinline__ void xcd_barrier(const XcdBarrier& b) {
    asm volatile("s_waitcnt vmcnt(0)" ::: "memory");
    __syncthreads();
    if (threadIdx.x == 0) {
        unsigned* bar = b.bar;
        __builtin_amdgcn_s_waitcnt(0);
        unsigned nloc = b.st[0], nx = b.st[1];
        if (nloc == 0u) { xcd_barrier_complete(bar, b.x, nloc, nx); b.st[0] = nloc; b.st[1] = nx; }
        const unsigned old = xb_add(&bar[XB_XSUB(b.x)], 1u);
        const unsigned gen = old / nloc;
        if (old + 1u == (gen + 1u) * nloc) {
            __builtin_amdgcn_fence(__ATOMIC_RELEASE, "agent");
            asm volatile("s_waitcnt vmcnt(0)" ::: "memory");
            const unsigned og = xb_add(&bar[XB_TOP], 1u);
            const unsigned tg = og / nx;
            if (og + 1u == (tg + 1u) * nx) xb_add(&bar[XB_TOPGEN], 1u);
            else XB_SPIN(xb_ld(&bar[XB_TOPGEN]) == tg, bar);
            __builtin_amdgcn_fence(__ATOMIC_ACQUIRE, "agent");
            xb_add(&bar[XB_XGEN(b.x)], 1u);
            asm volatile("s_waitcnt vmcnt(0)" ::: "memory");
        } else {
            XB_SPIN(xb_ld(&bar[XB_XGEN(b.x)]) == gen, bar);
            __builtin_amdgcn_fence(__ATOMIC_ACQUIRE, "agent");
            asm volatile("s_waitcnt vmcnt(0)" ::: "memory");
        }
    }
    __syncthreads();
}
constexpr int DM = 2048, NTP = 8192, NTS = 128, NTOK = NTP + NTS, MPAD = 8448;
constexpr int LDW = 18952, NIN = 18944;
constexpr int SEQ = 2048, NB = 4, SB = 32, ST = 4, MH = 4, DH = 512;
constexpr float LN_EPS = 1e-5f, DN_ALPHA = 1.189207115002721f, QM_SCALE = 0.04419417382415922f, QA_SCALE = 0.125f;
constexpr size_t O_YP = 0, O_YS = 16777216, O_CP = 17039360, O_NP = 21233664, O_MP = 21241856, O_KBP = 21241872, O_VBP = 21372944,
                 O_CS = 21504016, O_NS = 55058448, O_MS = 55123984, O_KBS = 55124112, O_VBS = 56172688, O_END = 57221264;
constexpr size_t MiB = 1u << 20;
constexpr size_t WS_CTL = 0, CTL_ZERO_BYTES = 1 * MiB;
constexpr size_t WS_WIN = 2 * MiB, WS_P = 2 * MiB  , WS_WPM = 76 * MiB, WS_WPA = 84 * MiB, WS_WOUT = 92 * MiB;
constexpr size_t WS_XB = 100 * MiB, WS_Y = 100 * MiB  ;
constexpr size_t WS_QM = 133 * MiB, WS_KM = 166 * MiB, WS_VM = 199 * MiB, WS_GM = 232 * MiB, WS_QA = 265 * MiB, WS_SZA = 298 * MiB, WS_SGM = 331 * MiB, WS_SGA = 364 * MiB;
constexpr size_t WS_KA = 397 * MiB, WS_VA = 402 * MiB, WS_HM = 407 * MiB, WS_BRM = 473 * MiB, WS_BRA = 506 * MiB, WS_IG = 539 * MiB, WS_LF = 540 * MiB, WS_END = 541 * MiB;
constexpr int CW_BAR = 4096;
constexpr int NWAVES = 8;
constexpr int RING_OFF = 0, RING_BYTES = 131072, LDSCTL_OFF = RING_BYTES, MISC_OFF = LDSCTL_OFF + 320, LDS_BYTES = 147456;
struct Frame {
    LAS unsigned char* lds; unsigned char* ldsg;
    volatile LAS unsigned* MISC; gu32* ctl;
    int tid, lane, wave, vcu, G;
    unsigned char* ws; float* out;
};
#define WSB(off) ((bf16*)(F.ws + (off)))
#define WSF(off) ((float*)(F.ws + (off)))
__device__ __forceinline__ float wave_sum(float v) {
#pragma unroll
    for (int o = 1; o < 64; o <<= 1) v += __shfl_xor(v, o);
    return v;
}
__device__ __forceinline__ float wave_max(float v) {
#pragma unroll
    for (int o = 1; o < 64; o <<= 1) v = fmaxf(v, __shfl_xor(v, o));
    return v;
}
__device__ __forceinline__ float bf2f(bf16 h) { return __uint_as_float((unsigned)h << 16); }
__device__ __forceinline__ float bflo(unsigned w) { return __uint_as_float(w << 16); }
__device__ __forceinline__ float bfhi(unsigned w) { return __uint_as_float(w & 0xffff0000u); }
__device__ __forceinline__ float log_sigmoid_f(float x) { return x >= 0.f ? -log1pf(expf(-x)) : x - log1pf(expf(x)); }

__device__ __forceinline__ void p0_transpose_tile(const float* W, int ldw, int srccol, int k0, bf16* WT, int K, int dstrow, LAS float* scr, int lane) {
#pragma unroll 8
    for (int i = 0; i < 32; ++i) { const int kk = 2 * i + (lane >> 5); scr[kk * 33 + (lane & 31)] = W[(size_t)(k0 + kk) * ldw + srccol + (lane & 31)]; }
    LDS_WAIT(); asm volatile("" ::: "memory");
    const int c = lane & 7;
#pragma unroll
    for (int j = 0; j < 4; ++j) { const int n = (lane >> 3) + 8 * j; const LAS float* s = scr + (8 * c) * 33 + n;
        v4u o; o.x = pk2(s[0 * 33], s[1 * 33]); o.y = pk2(s[2 * 33], s[3 * 33]); o.z = pk2(s[4 * 33], s[5 * 33]); o.w = pk2(s[6 * 33], s[7 * 33]);
        *(GAS v4u*)(WT + (size_t)(dstrow + n) * K + k0 + 8 * c) = o; }
    LDS_WAIT(); asm volatile("" ::: "memory");
}
__device__ __forceinline__ int win_src_col(int vn) {
    if (vn < 6144 || vn >= 10240) return vn;
    const int j = (vn - 6144) >> 8, i = (vn - 6144) & 255;
    return i < 128 ? 6144 + 128 * j + i : 8192 + 128 * j + (i - 128);
}
__device__ __forceinline__ void p0_prologue(Frame& F, const float* xp, const float* xs, const float* w_in, const float* wpm, const float* wpa, const float* wout, const float* b_i, const float* b_f, const float* sk, const float* sv) {
    const int gw = F.vcu * NWAVES + F.wave, NGW = F.G * NWAVES, lane = F.lane;
    {
        LAS float* scr = (LAS float*)(F.lds + RING_OFF + F.wave * 16384);
        constexpr int I_IN = 32 * (NIN / 32), I_SQ = 32 * 64, NITEMS = I_IN + 3 * I_SQ;
        for (int it = gw; it < NITEMS; it += NGW) {
            int r = it;
            if (r < I_IN) { const int kb = r / (NIN / 32), nb = r % (NIN / 32); p0_transpose_tile(w_in, LDW, win_src_col(32 * nb), 64 * kb, WSB(WS_WIN), DM, 32 * nb, scr, lane); continue; }
            r -= I_IN;
            const int which = r / I_SQ; r %= I_SQ; const int kb = r / 64, nb = r % 64;
            const float* W = which == 0 ? wpm : (which == 1 ? wpa : wout); bf16* WT = which == 0 ? WSB(WS_WPM) : (which == 1 ? WSB(WS_WPA) : WSB(WS_WOUT));
            p0_transpose_tile(W, DM, 32 * nb, 64 * kb, WT, DM, 32 * nb, scr, lane);
        }
    }
    __syncthreads();
    {
        LAS float* W8 = (LAS float*)(F.lds + RING_OFF);
        for (int idx = F.tid; idx < 2048 * 8; idx += NWAVES * 64) { const int k = idx >> 3, c = idx & 7;
            W8[(((k >> 8) * 4 + (k & 3)) * 64 + ((k >> 2) & 63)) * 8 + c] = w_in[(size_t)k * LDW + NIN + c]; }
        __syncthreads();
        for (int r = gw; r < MPAD; r += NGW) {
            f32x4 v[8];
            if (r < NTOK) { const GAS f32x4* xr = (const GAS f32x4*)(r < NTP ? xp + (size_t)r * DM : xs + (size_t)(r - NTP) * DM) + lane;
#pragma unroll
                for (int j = 0; j < 8; ++j) v[j] = xr[64 * j]; }
            else {
#pragma unroll
                for (int j = 0; j < 8; ++j) v[j] = (f32x4){0.f, 0.f, 0.f, 0.f}; }
            GAS unsigned long long* o8 = (GAS unsigned long long*)(WSB(WS_XB) + (size_t)r * DM) + lane;
#pragma unroll
            for (int j = 0; j < 8; ++j) o8[64 * j] = (unsigned long long)pk2(v[j].x, v[j].y) | ((unsigned long long)pk2(v[j].z, v[j].w) << 32);
            if (r < NTOK) {
                float a[8];
#pragma unroll
                for (int c = 0; c < 8; ++c) a[c] = 0.f;
#pragma unroll
                for (int j = 0; j < 8; ++j)
#pragma unroll
                    for (int e = 0; e < 4; ++e) { const LAS f32x4* wp = (const LAS f32x4*)(W8 + ((j * 4 + e) * 64 + lane) * 8); const f32x4 w0 = wp[0], w1 = wp[1]; const float xv = v[j][e];
                        a[0] += xv * w0[0]; a[1] += xv * w0[1]; a[2] += xv * w0[2]; a[3] += xv * w0[3]; a[4] += xv * w1[0]; a[5] += xv * w1[1]; a[6] += xv * w1[2]; a[7] += xv * w1[3]; }
#pragma unroll
                for (int c = 0; c < 8; ++c) a[c] = wave_sum(a[c]);
                if (lane < 8) {
                    const float s = lane == 0 ? a[0] : lane == 1 ? a[1] : lane == 2 ? a[2] : lane == 3 ? a[3] : lane == 4 ? a[4] : lane == 5 ? a[5] : lane == 6 ? a[6] : a[7];
                    if (lane < 4) WSF(WS_IG)[(size_t)r * 4 + lane] = s + b_i[lane];
                    else WSF(WS_LF)[(size_t)r * 4 + (lane - 4)] = log_sigmoid_f(s + b_f[lane - 4]);
                }
            }
        }
    }
    {
        const int gt = F.vcu * (NWAVES * 64) + F.tid, NGT = F.G * NWAVES * 64;
        const f32x4* sk4 = (const f32x4*)sk; const f32x4* sv4 = (const f32x4*)sv; f32x4* kb4 = (f32x4*)(F.out + O_KBS); f32x4* vb4 = (f32x4*)(F.out + O_VBS);
        for (int i = gt; i < SB * 124 * 64; i += NGT) { const int b = i / (124 * 64), rem = i % (124 * 64);
            kb4[(size_t)b * 128 * 64 + rem] = sk4[(size_t)b * 128 * 64 + 4 * 64 + rem]; vb4[(size_t)b * 128 * 64 + rem] = sv4[(size_t)b * 128 * 64 + 4 * 64 + rem]; }
        v4u* z = (v4u*)(WSB(WS_BRA) + (size_t)NTOK * DM);
        for (int i = gt; i < (MPAD - NTOK) * DM / 8; i += NGT) z[i] = (v4u){0u, 0u, 0u, 0u};
    }
}
__device__ __forceinline__ void mlstm_scalar_job(Frame& F, int r0, int T, int h, int vs, const float* C0, const float* n0, float m0, float* Cout, float* nout, float* mout) {
    float* sq = (float*)F.ldsg; float* sk = sq + 512; float* sv = sk + 512; float* red = sv + 32; float* redn = red + 512;
    const int tid = F.tid, v = tid & 31, kq = tid >> 5;
    float c[32];
#pragma unroll
    for (int i = 0; i < 32; ++i) c[i] = C0 ? C0[(size_t)(kq * 32 + i) * 512 + vs * 32 + v] : 0.f;
    float nreg = n0 ? n0[tid] : 0.f, m = m0;
    for (int t = 0; t < T; ++t) {
        const size_t r = (size_t)(r0 + t);
        sq[tid] = bf2f(WSB(WS_QM)[r * DM + h * 512 + tid]); sk[tid] = bf2f(WSB(WS_KM)[r * DM + h * 512 + tid]);
        if (tid < 32) sv[tid] = bf2f(WSB(WS_VM)[r * DM + h * 512 + vs * 32 + tid]);
        const float ig = WSF(WS_IG)[r * 4 + h], lf = WSF(WS_LF)[r * 4 + h];
        __syncthreads();
        const float mn = fmaxf(lf + m, ig), fd = expf(lf + m - mn), ii = expf(ig - mn);
        const float vv = sv[v] * ii; float part = 0.f;
#pragma unroll
        for (int i = 0; i < 32; ++i) { c[i] = fd * c[i] + sk[kq * 32 + i] * vv; part += sq[kq * 32 + i] * c[i]; }
        nreg = fd * nreg + ii * sk[tid];
        const float qn = wave_sum(sq[tid] * nreg);
        if (F.lane == 0) redn[F.wave] = qn;
        red[kq * 32 + v] = part;
        __syncthreads();
        if (tid < 32) {
            float num = 0.f, den = 0.f;
#pragma unroll
            for (int q = 0; q < 16; ++q) num += red[q * 32 + tid];
#pragma unroll
            for (int w = 0; w < 8; ++w) den += redn[w];
            WSF(WS_HM)[r * DM + h * 512 + vs * 32 + tid] = num / fmaxf(fabsf(den), expf(-mn));
        }
        m = mn;
    }
#pragma unroll
    for (int i = 0; i < 32; ++i) Cout[(size_t)(kq * 32 + i) * 512 + vs * 32 + v] = c[i];
    if (vs == 0) { nout[tid] = nreg; if (tid == 0) *mout = m; }
    __syncthreads();
}
__device__ __forceinline__ float swa_row(const unsigned* Ks, const bf16* Vs, int loc, int minvalid, float qv, float slope, float sink, int lane) {
    float a0 = 0.f, a1 = 0.f;
    const unsigned* k0 = Ks + (loc + lane) * 33; const unsigned* k1 = Ks + (loc + 64 + lane) * 33;
#pragma unroll 4
    for (int dd = 0; dd < 32; ++dd) {
        const float q0 = __int_as_float(__builtin_amdgcn_readlane(__float_as_int(qv), 2 * dd)), q1 = __int_as_float(__builtin_amdgcn_readlane(__float_as_int(qv), 2 * dd + 1));
        const unsigned w0 = k0[dd], w1 = k1[dd];
        a0 += bflo(w0) * q0 + bfhi(w0) * q1; a1 += bflo(w1) * q0 + bfhi(w1) * q1;
    }
    const float l0 = (loc + lane >= minvalid) ? a0 - slope * (float)(127 - lane) : -INFINITY;
    const float l1 = (loc + 64 + lane >= minvalid) ? a1 - slope * (float)(63 - lane) : -INFINITY;
    const float mx = fmaxf(wave_max(fmaxf(l0, l1)), sink);
    const float p0 = expf(l0 - mx), p1 = expf(l1 - mx);
    const float den = wave_sum(p0 + p1) + expf(sink - mx);
    float acc = 0.f;
    const bf16* vb = Vs + (size_t)loc * 64 + lane;
#pragma unroll 4
    for (int j = 0; j < 64; ++j) {
        const float pj0 = __int_as_float(__builtin_amdgcn_readlane(__float_as_int(p0), j)), pj1 = __int_as_float(__builtin_amdgcn_readlane(__float_as_int(p1), j));
        acc += pj0 * bf2f(vb[j * 64]) + pj1 * bf2f(vb[(64 + j) * 64]);
    }
    return acc / den;
}
__device__ __forceinline__ void swa_prompt_unit(Frame& F, const float* sinks, int b, int tt, int kvh) {
    unsigned* Ks = (unsigned*)F.ldsg; bf16* Vs = (bf16*)(F.ldsg + 192 * 33 * 4);
    const int t0 = 64 * tt, tid = F.tid;
    for (int i = tid; i < 192 * 32; i += NWAVES * 64) { const int row = i >> 5, dw = i & 31; const int s = t0 - 127 + row;
        unsigned kw = 0u, vw = 0u;
        if (s >= 0 && row < 191) { const size_t g = (size_t)(b * SEQ + s) * 128 + kvh * 32 + dw; kw = ((const unsigned*)WSB(WS_KA))[g]; vw = ((const unsigned*)WSB(WS_VA))[g]; }
        Ks[row * 33 + dw] = kw; ((unsigned*)Vs)[row * 32 + dw] = vw; }
    __syncthreads();
    const int minvalid = 127 - t0 > 0 ? 127 - t0 : 0;
    for (int i = 0; i < 8; ++i) {
        const int loc = F.wave * 8 + i; const size_t r = (size_t)(b * SEQ + t0 + loc);
        for (int g = 0; g < 8; ++g) {
            const int head = kvh * 8 + g; const size_t o = r * DM + kvh * 512 + g * 64 + F.lane;
            const float res = swa_row(Ks, Vs, loc, minvalid, bf2f(WSB(WS_QA)[o]), exp2f(-0.25f * (float)(head + 1)), sinks[head], F.lane);
            WSB(WS_BRA)[o] = (bf16)f2bf(res * bf2f(WSB(WS_SZA)[o]));
        }
    }
    __syncthreads();
}
__device__ __forceinline__ void swa_sample_unit(Frame& F, const float* sinks, const float* sk, const float* sv, int b, int kvh) {
    unsigned* Ks = (unsigned*)F.ldsg; bf16* Vs = (bf16*)(F.ldsg + 192 * 33 * 4);
    const int tid = F.tid;
    for (int i = tid; i < 192 * 32; i += NWAVES * 64) { const int row = i >> 5, dw = i & 31;
        unsigned kw = 0u, vw = 0u;
        if (row < 128) { const size_t g = ((size_t)(b * 128 + row) * 4 + kvh) * 64 + 2 * dw; kw = pk2(sk[g], sk[g + 1]); vw = pk2(sv[g], sv[g + 1]); }
        else if (row < 132) { const size_t g = (size_t)(NTP + b * 4 + row - 128) * 128 + kvh * 32 + dw; kw = ((const unsigned*)WSB(WS_KA))[g]; vw = ((const unsigned*)WSB(WS_VA))[g]; }
        Ks[row * 33 + dw] = kw; ((unsigned*)Vs)[row * 32 + dw] = vw; }
    __syncthreads();
    const int t = F.wave & 3; const size_t r = (size_t)(NTP + b * 4 + t);
    for (int gg = 0; gg < 4; ++gg) {
        const int g = (F.wave >> 2) * 4 + gg, head = kvh * 8 + g; const size_t o = r * DM + kvh * 512 + g * 64 + F.lane;
        const float res = swa_row(Ks, Vs, t + 1, 0, bf2f(WSB(WS_QA)[o]), exp2f(-0.25f * (float)(head + 1)), sinks[head], F.lane);
        WSB(WS_BRA)[o] = (bf16)f2bf(res * bf2f(WSB(WS_SZA)[o]));
    }
    __syncthreads();
}
__device__ __forceinline__ void p2_mixers_scalar(Frame& F, const float* sC, const float* sn, const float* sm, const float* sk, const float* sv, const float* sinks) {
    constexpr int J_MP = 256, J_MS = J_MP + SB * MH * 16, J_AP = J_MS + NB * 32 * 4, J_AS = J_AP + SB * 4;
    for (int j = F.vcu; j < J_AS; j += F.G) {
        if (j < J_MP) { const int bh = j >> 4, vs = j & 15, b = bh >> 2, h = bh & 3;
            mlstm_scalar_job(F, b * SEQ, SEQ, h, vs, nullptr, nullptr, 0.f, F.out + O_CP + (size_t)bh * 512 * 512, F.out + O_NP + (size_t)bh * 512, F.out + O_MP + bh); }
        else if (j < J_MS) { const int q = j - J_MP, bh = q >> 4, vs = q & 15, b = bh >> 2, h = bh & 3;
            mlstm_scalar_job(F, NTP + b * ST, ST, h, vs, sC + (size_t)bh * 512 * 512, sn + (size_t)bh * 512, sm[bh], F.out + O_CS + (size_t)bh * 512 * 512, F.out + O_NS + (size_t)bh * 512, F.out + O_MS + bh); }
        else if (j < J_AP) { const int q = j - J_MS; swa_prompt_unit(F, sinks, q >> 7, (q >> 2) & 31, q & 3); }
        else { const int q = j - J_AP; swa_sample_unit(F, sinks, sk, sv, q >> 2, q & 3); }
    }
}
__device__ __forceinline__ void p3_brm(Frame& F, const float* nw) {
    const int gw = F.vcu * NWAVES + F.wave, NGW = F.G * NWAVES, lane = F.lane;
    for (int r = gw; r < MPAD; r += NGW) {
        if (r >= NTOK) { ((v4u*)(WSB(WS_BRM) + (size_t)r * DM))[lane] = (v4u){0u, 0u, 0u, 0u}; ((v4u*)(WSB(WS_BRM) + (size_t)r * DM))[64 + lane] = (v4u){0u, 0u, 0u, 0u};
                         ((v4u*)(WSB(WS_BRM) + (size_t)r * DM))[128 + lane] = (v4u){0u, 0u, 0u, 0u}; ((v4u*)(WSB(WS_BRM) + (size_t)r * DM))[192 + lane] = (v4u){0u, 0u, 0u, 0u}; continue; }
#pragma unroll
        for (int hh = 0; hh < 4; ++hh) {
            const size_t o = (size_t)r * DM + hh * 512 + lane * 8;
            const f32x4 a = *(const f32x4*)(WSF(WS_HM) + o), b = *(const f32x4*)(WSF(WS_HM) + o + 4);
            const float mean = wave_sum((a[0] + a[1]) + (a[2] + a[3]) + (b[0] + b[1]) + (b[2] + b[3])) * (1.f / 512.f);
            const f32x4 da = a - mean, db = b - mean;
            const float var = wave_sum((da[0] * da[0] + da[1] * da[1]) + (da[2] * da[2] + da[3] * da[3]) + (db[0] * db[0] + db[1] * db[1]) + (db[2] * db[2] + db[3] * db[3])) * (1.f / 512.f);
            const float rstd = 1.0f / sqrtf(var + LN_EPS);
            const f32x4 w0 = *(const f32x4*)(nw + hh * 512 + lane * 8), w1 = *(const f32x4*)(nw + hh * 512 + lane * 8 + 4);
            const v4u g = *(const v4u*)(WSB(WS_GM) + o);
            v4u w;
            w.x = pk2(da[0] * rstd * w0[0] * bflo(g.x), da[1] * rstd * w0[1] * bfhi(g.x)); w.y = pk2(da[2] * rstd * w0[2] * bflo(g.y), da[3] * rstd * w0[3] * bfhi(g.y));
            w.z = pk2(db[0] * rstd * w1[0] * bflo(g.z), db[1] * rstd * w1[1] * bfhi(g.z)); w.w = pk2(db[2] * rstd * w1[2] * bflo(g.w), db[3] * rstd * w1[3] * bfhi(g.w));
            *(v4u*)(WSB(WS_BRM) + o) = w;
        }
    }
}
__device__ __forceinline__ void p6_ln(Frame& F, const float* lnw, const float* lnb) {
    const int gw = F.vcu * NWAVES + F.wave, NGW = F.G * NWAVES, lane = F.lane;
    for (int r = gw; r < NTOK; r += NGW) {
        f32x4* row = (f32x4*)(F.out + (size_t)r * DM) + lane;
        f32x4 v[8]; float s = 0.f;
#pragma unroll
        for (int j = 0; j < 8; ++j) { v[j] = row[64 * j]; s += (v[j][0] + v[j][1]) + (v[j][2] + v[j][3]); }
        const float mean = wave_sum(s) * (1.f / DM); float s2 = 0.f;
#pragma unroll
        for (int j = 0; j < 8; ++j) { v[j] = v[j] - mean; s2 += (v[j][0] * v[j][0] + v[j][1] * v[j][1]) + (v[j][2] * v[j][2] + v[j][3] * v[j][3]); }
        const float rstd = 1.0f / sqrtf(wave_sum(s2) * (1.f / DM) + LN_EPS);
#pragma unroll
        for (int j = 0; j < 8; ++j) { const f32x4 w = ((const f32x4*)lnw)[lane + 64 * j], bb = ((const f32x4*)lnb)[lane + 64 * j]; row[64 * j] = v[j] * rstd * w + bb; }
    }
}
constexpr int N_LAUNCHES = MK_N_LAUNCHES;
constexpr int PER_PHASE = 7;
struct Args { const float* in[17]; float* out; unsigned char* ws; int ph_lo, ph_hi; };
__global__ void __launch_bounds__(NWAVES * 64, 2) hybrid_fwd(Args args) {
    extern __shared__ __attribute__((aligned(16))) unsigned char lds[];
    Frame F;
    F.lds = (LAS unsigned char*)lds; F.ldsg = lds;
    F.MISC = (volatile LAS unsigned*)(F.lds + MISC_OFF);
    F.tid = threadIdx.x; F.lane = F.tid & 63; F.wave = __builtin_amdgcn_readfirstlane(F.tid >> 6);
    F.G = gridDim.x; { const int bx = blockIdx.x; F.vcu = (F.G % 8 == 0) ? (bx % 8) * (F.G / 8) + bx / 8 : bx; }
    unsigned char* ws = args.ws;
    F.ctl = (gu32*)(ws + WS_CTL);
    F.ws = ws; F.out = args.out;
    for (int u = F.tid; u < (LDS_BYTES - LDSCTL_OFF) / 4; u += NWAVES * 64) ((LAS unsigned*)(F.lds + LDSCTL_OFF))[u] = 0u;
    __syncthreads();
    XcdBarrier bar; bar.bar = (unsigned*)(F.ctl + CW_BAR); bar.x = 0; bar.st = nullptr;
    if (N_LAUNCHES == 1) bar = xcd_barrier_post((unsigned*)(F.ctl + CW_BAR), F.MISC + 8);
    const int lo = args.ph_lo, hi = args.ph_hi;
#ifndef PHASE_MASK
#define PHASE_MASK 0x7f
#endif
#define IN(k) (((PHASE_MASK >> (k)) & 1) && lo <= (k) && (k) < hi)
#define SEAM(k) do { if (IN(k) && IN((k) + 1)) xcd_barrier(bar); } while (0)
    if (IN(0)) { p0_prologue(F, args.in[0], args.in[1], args.in[7], args.in[12], args.in[13], args.in[14], args.in[8], args.in[9], args.in[5], args.in[6]); SEAM(0); }
    if (IN(1)) {
        pg8::Gemm g{WSB(WS_XB), WSB(WS_WIN), MPAD, NIN, DM}; pg8::StaticOrder S; S.init(MPAD, NIN, F.G, (int)blockIdx.x);
        pg8::EpiInProj E{F.ws, F.out};
        pg8::gemm_phase<pg8::EpiInProj, pg8::StaticOrder, true, true>(F.lds + RING_OFF, g, S, E);
        SEAM(1);
    }
    if (IN(2)) { p2_mixers_scalar(F, args.in[2], args.in[3], args.in[4], args.in[5], args.in[6], args.in[11]); SEAM(2); }
    if (IN(3)) {
        p3_brm(F, args.in[10]);
        pg8::Gemm g{WSB(WS_BRA), WSB(WS_WPA), MPAD, DM, DM}; pg8::StaticOrder S; S.init(MPAD, DM, F.G, (int)blockIdx.x);
        pg8::EpiPA E{WSB(WS_SGA), WSF(WS_P)};
        pg8::gemm_phase<pg8::EpiPA, pg8::StaticOrder, true, true>(F.lds + RING_OFF, g, S, E);
        SEAM(3);
    }
    if (IN(4)) {
        pg8::Gemm g{WSB(WS_BRM), WSB(WS_WPM), MPAD, DM, DM}; pg8::StaticOrder S; S.init(MPAD, DM, F.G, (int)blockIdx.x);
        pg8::EpiY E{WSB(WS_SGM), WSF(WS_P), WSB(WS_Y)};
        pg8::gemm_phase<pg8::EpiY, pg8::StaticOrder, true, true>(F.lds + RING_OFF, g, S, E);
        SEAM(4);
    }
    if (IN(5)) {
        pg8::Gemm g{WSB(WS_Y), WSB(WS_WOUT), MPAD, DM, DM}; pg8::StaticOrder S; S.init(MPAD, DM, F.G, (int)blockIdx.x);
        pg8::EpiOut E{args.in[0], args.in[1], F.out, DN_ALPHA};
        pg8::gemm_phase<pg8::EpiOut, pg8::StaticOrder, true, true>(F.lds + RING_OFF, g, S, E);
        SEAM(5);
    }
    if (IN(6)) p6_ln(F, args.in[15], args.in[16]);
#undef IN
#undef SEAM
}

extern "C" void kernel_launch(void* const* d_in, const int* in_sizes, int n_in, void* d_out, int out_size, void* d_ws, size_t ws_size, hipStream_t stream) {
    static int grid = 0;
    if (grid == 0) {
        if (n_in != 17 || out_size != (int)O_END || ws_size < WS_END) { fprintf(stderr, "kernel_launch: unexpected problem (n_in %d, out %d, ws %zu); nothing launched\n", n_in, out_size, ws_size); grid = -1; return; }
        int dev = 0, cus = 0, per_cu = 0;
        if (hipGetDevice(&dev) != hipSuccess || hipDeviceGetAttribute(&cus, hipDeviceAttributeMultiprocessorCount, dev) != hipSuccess) { fprintf(stderr, "kernel_launch: device query failed\n"); grid = -1; return; }
        if (hipFuncSetAttribute((const void*)hybrid_fwd, hipFuncAttributeMaxDynamicSharedMemorySize, LDS_BYTES) != hipSuccess) { fprintf(stderr, "kernel_launch: hipFuncSetAttribute failed\n"); grid = -1; return; }
        if (hipOccupancyMaxActiveBlocksPerMultiprocessor(&per_cu, (const void*)hybrid_fwd, NWAVES * 64, LDS_BYTES) != hipSuccess || per_cu < 1) { fprintf(stderr, "kernel_launch: occupancy query says %d blocks per CU\n", per_cu); (void)hipGetLastError(); grid = -1; return; }
        grid = cus;
    }
    if (grid < 0) return;
    (void)hipMemsetAsync((char*)d_ws + WS_CTL, 0, CTL_ZERO_BYTES, stream);
    Args a{};
    for (int i = 0; i < 17; ++i) a.in[i] = (const float*)d_in[i];
    a.out = (float*)d_out; a.ws = (unsigned char*)d_ws;
    if (N_LAUNCHES == 1) { a.ph_lo = 0; a.ph_hi = PER_PHASE; hipLaunchKernelGGL(hybrid_fwd, dim3(grid), dim3(NWAVES * 64), LDS_BYTES, stream, a); }
    else for (int li = 0; li < PER_PHASE; ++li) { a.ph_lo = li; a.ph_hi = li + 1; hipLaunchKernelGGL(hybrid_fwd, dim3(grid), dim3(NWAVES * 64), LDS_BYTES, stream, a); }
    const hipError_t le = hipPeekAtLastError();
    if (le != hipSuccess) fprintf(stderr, "kernel_launch: launch failed: %s\n", hipGetErrorName(le));
}
```

```cpp
#include <hip/hip_runtime.h>
#include <cstdio>
#include <cstdint>
#include <cmath>
#ifndef MK_N_LAUNCHES
#define MK_N_LAUNCHES 1
#endif
#define P2_ML 1
namespace pg8 {
#define PG8_LAS __attribute__((address_space(3)))
typedef unsigned short bf16_t;
typedef short bf16x8 __attribute__((ext_vector_type(8)));
typedef float f32x4 __attribute__((ext_vector_type(4)));
typedef unsigned u32x4 __attribute__((ext_vector_type(4)));
constexpr int BM = 256, BK = 64, HALF = 128, HTB = HALF * BK * 2  , STAGE_BYTES = 8 * HTB, NXCD = 8, WGM = 8;

__host__ __device__ __forceinline__ int lds_byte(int r, int c) { const int st = (r >> 4) * 2 + (c >> 5), rr = r & 15, cc = c & 31, ob = rr * 64 + cc * 2; return st * 1024 + (ob ^ (((ob >> 9) & 1) << 5)); }
__host__ __device__ __forceinline__ void stage_rc(int b, int& R, int& C) { const int st = b / 1024, sb = b % 1024, swz = sb ^ (((sb >> 9) & 1) << 5); R = (st >> 1) * 16 + swz / 64; C = (st & 1) * 32 + (swz % 64) / 2; }
__host__ __device__ __forceinline__ int perm32(int rho) { const int n = rho >> 4, i = rho & 15; return 8 * (i >> 2) + 4 * n + (i & 3); }

struct Unit { int pm, pn; };
struct Gemm { const bf16_t* A; const bf16_t* Bt; int M, N, K; };

struct StaticOrder {
    int nM, nN, nwg, G, c;
    __host__ __device__ void init(int M, int N, int G_, int c_) { nM = M / BM; nN = N / BM; nwg = nM * nN; G = G_; c = c_; }
    __host__ __device__ bool next(int i, Unit& u) const {
        const long L = (long)i * G + c; if (L >= nwg) return false;
        int wgid = (int)L; { const int q = nwg / NXCD, r = nwg % NXCD, xcd = wgid % NXCD, off = wgid / NXCD; wgid = (xcd < r ? xcd * (q + 1) : r * (q + 1) + (xcd - r) * q) + off; }
        const int nig = WGM * nN, gid = wgid / nig, fm = gid * WGM, gsz = (nM - fm) < WGM ? (nM - fm) : WGM;
        u.pm = fm + ((wgid % nig) % gsz); u.pn = (wgid % nig) / gsz; return true;
    }
    __device__ __forceinline__ void a_ready(const Unit&) const {}
    __device__ __forceinline__ void done(const Unit&) const {}
};

__device__ __forceinline__ unsigned cvt_pk_bf16(float lo, float hi) { unsigned r; asm volatile("v_cvt_pk_bf16_f32 %0, %1, %2" : "=v"(r) : "v"(lo), "v"(hi)); return r; }
typedef float f32x2 __attribute__((ext_vector_type(2)));
__device__ __forceinline__ f32x2 gelu_pk(f32x2 v) {
    const f32x2 av = __builtin_elementwise_abs(v), d = av * 0.2316418882f + 1.0f;
    f32x2 t; t.x = __builtin_amdgcn_rcpf(d.x); t.y = __builtin_amdgcn_rcpf(d.y);
    f32x2 q = t * 0.5307027145f + (-0.7265760135f); q = q * t + 0.7107068705f; q = q * t + (-0.142248368f); q = q * t + 0.127414796f; q = q * t;
    const f32x2 s = (v * v) * (-0.72134752044f);
    f32x2 e; e.x = __builtin_amdgcn_exp2f(s.x); e.y = __builtin_amdgcn_exp2f(s.y);
    const f32x2 m = v * (q * e), r = v - m;
    f32x2 o; o.x = v.x < 0.f ? m.x : r.x; o.y = v.y < 0.f ? m.y : r.y; return o;
}

template <int ACT  > struct EpiBf16 {
    static constexpr bool PERM = true, AFTER_DRAIN = false; static_assert(ACT == 0 || ACT == 1, "EpiBf16: ACT is 0 (none) or 1 (gelu_pk)");
    bf16_t* O; int ldc; const float* bias; int split_cols; size_t split_stride; float scale0;
    __device__ __forceinline__ void operator()(const f32x4 (&acc)[2][2][4][2], const Unit& u, int wr, int wc, int fr, int fq) const {
        const int row0 = u.pm * BM + wr * 64 + fr; int colt = u.pn * BM; bf16_t* base = O;
        float sc = 1.f; if (split_cols) { const int t = colt / split_cols; base += (size_t)t * split_stride; colt -= t * split_cols; if (t == 0) sc = scale0; }
        const int col0 = colt + wc * 32 + 8 * fq, bcol0 = u.pn * BM + wc * 32 + 8 * fq;
        f32x4 bv[2][2];
#pragma unroll
        for (int bj = 0; bj < 2; ++bj)
#pragma unroll
            for (int n = 0; n < 2; ++n) bv[bj][n] = bias ? *(const f32x4*)(bias + bcol0 + bj * HALF + 4 * n) : (f32x4){0.f, 0.f, 0.f, 0.f};
#pragma unroll
        for (int ai = 0; ai < 2; ++ai)
#pragma unroll
            for (int m = 0; m < 4; ++m) { bf16_t* rowp = base + (size_t)(row0 + ai * HALF + m * 16) * ldc + col0;
#pragma unroll
                for (int bj = 0; bj < 2; ++bj) { f32x4 v0 = acc[ai][bj][m][0] + bv[bj][0], v1 = acc[ai][bj][m][1] + bv[bj][1];
                    if (ACT == 1) { f32x2 a = gelu_pk((f32x2){v0[0], v0[1]}), b = gelu_pk((f32x2){v0[2], v0[3]}), c = gelu_pk((f32x2){v1[0], v1[1]}), d = gelu_pk((f32x2){v1[2], v1[3]});
                        v0 = (f32x4){a.x, a.y, b.x, b.y}; v1 = (f32x4){c.x, c.y, d.x, d.y}; }
                    v0 = v0 * sc; v1 = v1 * sc; u32x4 w; w.x = cvt_pk_bf16(v0[0], v0[1]); w.y = cvt_pk_bf16(v0[2], v0[3]); w.z = cvt_pk_bf16(v1[0], v1[1]); w.w = cvt_pk_bf16(v1[2], v1[3]);
                    *(u32x4*)(rowp + bj * HALF) = w; } }
    }
};

struct PanelStats {
    unsigned* xbuf;
    unsigned* cnt;
    unsigned* tmo;
    int ntn; float eps;
    unsigned code;
    __device__ __forceinline__ bool run(const f32x4 (&v)[2][2][4][2], const Unit& u, int wr, int wc, int fr, int fq, PG8_LAS unsigned char* lds, int wid, int lane) const {
        typedef float f32x2v __attribute__((ext_vector_type(2)));
        PG8_LAS f32x2v* P = (PG8_LAS f32x2v*)lds;
        PG8_LAS f32x2v* S = (PG8_LAS f32x2v*)(lds + 8192);
        PG8_LAS unsigned* flag = (PG8_LAS unsigned*)(lds + 8192 + 2048);
#pragma unroll
        for (int ai = 0; ai < 2; ++ai)
#pragma unroll
            for (int m = 0; m < 4; ++m) {
                float s = 0.f;
#pragma unroll
                for (int bj = 0; bj < 2; ++bj)
#pragma unroll
                    for (int n = 0; n < 2; ++n) { const f32x4 x = v[ai][bj][m][n]; s += (x[0] + x[1]) + (x[2] + x[3]); }
                s += __shfl_xor(s, 16); s += __shfl_xor(s, 32);
                const float mw = s * (1.0f / 64.0f); float q = 0.f;
#pragma unroll
                for (int bj = 0; bj < 2; ++bj)
#pragma unroll
                    for (int n = 0; n < 2; ++n) { const f32x4 d = v[ai][bj][m][n] - mw; q += (d[0] * d[0] + d[1] * d[1]) + (d[2] * d[2] + d[3] * d[3]); }
                q += __shfl_xor(q, 16); q += __shfl_xor(q, 32);
                if (fq == 0) P[(ai * HALF + wr * 64 + m * 16 + fr) * 4 + wc] = (f32x2v){mw, q};
            }
        asm volatile("s_waitcnt lgkmcnt(0)" ::: "memory"); __builtin_amdgcn_s_barrier(); asm volatile("" ::: "memory");
#if defined(BROKEN_EXCHANGE_NO_WAIT)
#warning BROKEN CONTROL BUILD: the row-statistics exchange does not wait; results are wrong by design
        if (blockIdx.x >= 64) { const long long t0_ = clock64(); while (clock64() - t0_ < 60000) __builtin_amdgcn_s_sleep(8); }
#endif
        const int row = wid * 32 + (lane & 31);
        if (lane < 32) {
            const f32x2v a = P[row * 4 + 0], b = P[row * 4 + 1], c = P[row * 4 + 2], d = P[row * 4 + 3];
            const float mt = (a.x + b.x + c.x + d.x) * 0.25f;
            const float da = a.x - mt, db = b.x - mt, dc = c.x - mt, dd = d.x - mt;
            const float m2 = (a.y + b.y) + (c.y + d.y) + 64.0f * ((da * da + db * db) + (dc * dc + dd * dd));
            unsigned long long* slot = (unsigned long long*)xbuf + ((size_t)(u.pm * BM + row) * 4 + u.pn);
            __hip_atomic_store(slot, ((unsigned long long)__float_as_uint(m2) << 32) | __float_as_uint(mt), __ATOMIC_RELAXED, __HIP_MEMORY_SCOPE_AGENT);
        }
        asm volatile("s_waitcnt vmcnt(0)" ::: "memory");
        if (lane == 0) __hip_atomic_fetch_add(cnt + 64 * u.pm, 1u, __ATOMIC_RELAXED, __HIP_MEMORY_SCOPE_AGENT);
        if (wid == 0) {
            bool dead = false; const unsigned long long t0 = __builtin_amdgcn_s_memrealtime(); const unsigned want = 8u * (unsigned)ntn;
            for (;;) {
#if defined(BROKEN_EXCHANGE_NO_WAIT)
                break;
#endif
                if ((unsigned)__builtin_amdgcn_readfirstlane(__hip_atomic_load(cnt + 64 * u.pm, __ATOMIC_RELAXED, __HIP_MEMORY_SCOPE_AGENT)) >= want) break;
                if (__builtin_amdgcn_s_memrealtime() - t0 > 2000000ull) {
                    if (lane == 0) { unsigned expect = 0u; __hip_atomic_compare_exchange_strong(tmo + 1, &expect, code | (unsigned)(u.pm & 0xff), __ATOMIC_RELAXED, __ATOMIC_RELAXED, __HIP_MEMORY_SCOPE_AGENT);
                                     __hip_atomic_store(tmo, 1u, __ATOMIC_RELAXED, __HIP_MEMORY_SCOPE_AGENT); }
                    dead = true; break; }
                __builtin_amdgcn_s_sleep(2);
            }
            __builtin_amdgcn_fence(__ATOMIC_ACQUIRE, "agent");
            if (lane == 0) flag[0] = dead ? 1u : 0u;
        }
        asm volatile("s_waitcnt vmcnt(0) lgkmcnt(0)" ::: "memory"); __builtin_amdgcn_s_barrier(); asm volatile("" ::: "memory");
        const bool bad = flag[0] != 0u;
        if (lane < 32) {
            const unsigned long long* slot = (const unsigned long long*)xbuf + (size_t)(u.pm * BM + row) * 4; float mt[4], m2[4]; float ms = 0.f;
#pragma unroll
            for (int t = 0; t < 4; ++t) { if (t < ntn) { const unsigned long long w = __hip_atomic_load(slot + t, __ATOMIC_RELAXED, __HIP_MEMORY_SCOPE_AGENT); mt[t] = __uint_as_float((unsigned)w); m2[t] = __uint_as_float((unsigned)(w >> 32)); } else { mt[t] = 0.f; m2[t] = 0.f; } ms += mt[t]; }
            const float mean = ms / (float)ntn; float q = 0.f;
#pragma unroll
            for (int t = 0; t < 4; ++t) if (t < ntn) { const float dm = mt[t] - mean; q += m2[t] + 256.0f * dm * dm; }
            S[row] = (f32x2v){mean, 1.0f / sqrtf(q / (256.0f * (float)ntn) + eps)};
        }
        asm volatile("s_waitcnt lgkmcnt(0)" ::: "memory"); __builtin_amdgcn_s_barrier(); asm volatile("" ::: "memory");
        return bad;
    }
};
struct EpiLnRes {
    static constexpr bool PERM = false, AFTER_DRAIN = true;
    const float* base; float* out; int ldc; const float* bias; PanelStats st; unsigned poison;
    __device__ __forceinline__ void fused(f32x4 (&acc)[2][2][4][2], const Unit& u, int wr, int wc, int fr, int fq, PG8_LAS unsigned char* lds, int wid, int lane) const {
        typedef float f32x2v __attribute__((ext_vector_type(2)));
        const PG8_LAS f32x2v* S = (const PG8_LAS f32x2v*)(lds + 8192);
        const int col0 = u.pn * BM + wc * 32 + 4 * fq;
#pragma unroll
        for (int bj = 0; bj < 2; ++bj)
#pragma unroll
            for (int n = 0; n < 2; ++n) { const f32x4 bv = bias ? *(const f32x4*)(bias + col0 + bj * HALF + n * 16) : (f32x4){0.f, 0.f, 0.f, 0.f};
#pragma unroll
                for (int ai = 0; ai < 2; ++ai)
#pragma unroll
                    for (int m = 0; m < 4; ++m) acc[ai][bj][m][n] += bv; }
        f32x4 pre[4][2][2];
#pragma unroll
        for (int m = 0; m < 4; ++m) { const size_t off = (size_t)(u.pm * BM + wr * 64 + m * 16 + fr) * ldc + col0;
#pragma unroll
            for (int bj = 0; bj < 2; ++bj)
#pragma unroll
                for (int n = 0; n < 2; ++n) pre[m][bj][n] = *(const f32x4*)(base + off + bj * HALF + n * 16); }
        const bool bad = st.run(acc, u, wr, wc, fr, fq, lds, wid, lane) || poison != 0u;
        const float qnan = __builtin_nanf("");
#pragma unroll
        for (int ai = 0; ai < 2; ++ai)
#pragma unroll
            for (int m = 0; m < 4; ++m) { const int r = ai * HALF + wr * 64 + m * 16 + fr; const f32x2v sr = S[r]; const size_t off = (size_t)(u.pm * BM + r) * ldc + col0;
#pragma unroll
                for (int bj = 0; bj < 2; ++bj)
#pragma unroll
                    for (int n = 0; n < 2; ++n) { const f32x4 bs = ai == 0 ? pre[m][bj][n] : *(const f32x4*)(base + off + bj * HALF + n * 16); f32x4 o = bs + (acc[ai][bj][m][n] - sr.x) * sr.y;
                        if (bad) o = (f32x4){qnan, qnan, qnan, qnan}; *(f32x4*)(out + off + bj * HALF + n * 16) = o; }
                if (m & 1) asm volatile("" ::: "memory"); }
    }
};
struct EpiLnResLn {
    static constexpr bool PERM = false, AFTER_DRAIN = true;
    const float* base; float* out; bf16_t* xn; int ldc; const float* bias; PanelStats st1, st2; unsigned poison;
    __device__ __forceinline__ void fused(f32x4 (&acc)[2][2][4][2], const Unit& u, int wr, int wc, int fr, int fq, PG8_LAS unsigned char* lds, int wid, int lane) const {
        typedef float f32x2v __attribute__((ext_vector_type(2))); typedef unsigned u32x2v __attribute__((ext_vector_type(2)));
        const PG8_LAS f32x2v* S = (const PG8_LAS f32x2v*)(lds + 8192);
        const int col0 = u.pn * BM + wc * 32 + 4 * fq;
#pragma unroll
        for (int bj = 0; bj < 2; ++bj)
#pragma unroll
            for (int n = 0; n < 2; ++n) { const f32x4 bv = bias ? *(const f32x4*)(bias + col0 + bj * HALF + n * 16) : (f32x4){0.f, 0.f, 0.f, 0.f};
#pragma unroll
                for (int ai = 0; ai < 2; ++ai)
#pragma unroll
                    for (int m = 0; m < 4; ++m) acc[ai][bj][m][n] += bv; }
        bool bad = st1.run(acc, u, wr, wc, fr, fq, lds, wid, lane) || poison != 0u;
        const float qnan = __builtin_nanf("");
#pragma unroll
        for (int ai = 0; ai < 2; ++ai)
#pragma unroll
            for (int m = 0; m < 4; ++m) { const int r = ai * HALF + wr * 64 + m * 16 + fr; const f32x2v sr = S[r]; const size_t off = (size_t)(u.pm * BM + r) * ldc + col0;
#pragma unroll
                for (int bj = 0; bj < 2; ++bj)
#pragma unroll
                    for (int n = 0; n < 2; ++n) { const f32x4 bs = *(const f32x4*)(base + off + bj * HALF + n * 16); acc[ai][bj][m][n] = bs + (acc[ai][bj][m][n] - sr.x) * sr.y; }
                asm volatile("" : "+v"(acc[ai][0][m][0]), "+v"(acc[ai][0][m][1]), "+v"(acc[ai][1][m][0]), "+v"(acc[ai][1][m][1]));
                if (m & 1) asm volatile("" ::: "memory"); }
        const bool bad1 = bad;
        bad = st2.run(acc, u, wr, wc, fr, fq, lds, wid, lane) || bad;
#pragma unroll
        for (int ai = 0; ai < 2; ++ai)
#pragma unroll
            for (int m = 0; m < 4; ++m) { const int r = ai * HALF + wr * 64 + m * 16 + fr; const f32x2v sr = S[r]; const size_t off = (size_t)(u.pm * BM + r) * ldc + col0;
#pragma unroll
                for (int bj = 0; bj < 2; ++bj)
#pragma unroll
                    for (int n = 0; n < 2; ++n) { const f32x4 x1 = acc[ai][bj][m][n]; *(f32x4*)(out + off + bj * HALF + n * 16) = bad1 ? (f32x4){qnan, qnan, qnan, qnan} : x1;
                        const f32x4 o = (x1 - sr.x) * sr.y; u32x2v w; w.x = cvt_pk_bf16(o[0], o[1]); w.y = cvt_pk_bf16(o[2], o[3]);
                        if (bad) { w.x = 0x7fc07fc0u; w.y = 0x7fc07fc0u; } *(u32x2v*)(xn + off + bj * HALF + n * 16) = w; }
                asm volatile("" ::: "memory"); }
    }
};

template <class Epi, class Sched, bool ALIGN_EPI = false, bool SP2 = false>
__device__ __forceinline__ void gemm_phase(PG8_LAS unsigned char* lds, const Gemm g, const Sched& S, const Epi& E) {
    const int tid = threadIdx.x, wid = __builtin_amdgcn_readfirstlane(tid >> 6), lane = tid & 63, wr = wid >> 2, wc = wid & 3, fr = lane & 15, fq = lane >> 4;
    const int K = g.K, nt = K / BK;
    unsigned voffA[2], voffB[2];
#pragma unroll
    for (int i = 0; i < 2; ++i) { int R, C; stage_rc(tid * 16 + i * 8192, R, C); const int Rb = Epi::PERM ? ((R & ~31) + perm32(R & 31)) : R;
        voffA[i] = (unsigned)(R * K + C) * 2u; voffB[i] = (unsigned)(Rb * K + C) * 2u; }
    const size_t kstep = (size_t)(BK * 2);
    const size_t hstep = (size_t)HALF * K * 2;
    const size_t tstep = 2 * hstep;
    const unsigned ldsw = (unsigned)wid * 1024u;
    const int aoff = lds_byte(wr * 64 + fr, fq * 8), boff = lds_byte(wc * 32 + fr, fq * 8);
#define PG8_SA(b, h) (((b) * 2 + (h)) * HTB)
#define PG8_SB(b, h) ((4 + (b) * 2 + (h)) * HTB)
#define PG8_STAGE(bufoff, gbase, voff) do { _Pragma("unroll") for (int _i = 0; _i < 2; ++_i) \
        __builtin_amdgcn_global_load_lds((const unsigned*)((const char*)(gbase) + (voff)[_i]), (PG8_LAS unsigned*)(lds + (bufoff) + ldsw + _i * 8192), 16, 0, 0); } while (0)
#define PG8_LDA(dst, b, h) do { _Pragma("unroll") for (int m = 0; m < 4; ++m) _Pragma("unroll") for (int k = 0; k < 2; ++k) dst[m][k] = *(const PG8_LAS bf16x8*)(lds + PG8_SA(b, h) + aoff + m * 2048 + k * 1024); } while (0)
#define PG8_LDB(dst, b, h) do { _Pragma("unroll") for (int n = 0; n < 2; ++n) _Pragma("unroll") for (int k = 0; k < 2; ++k) dst[n][k] = *(const PG8_LAS bf16x8*)(lds + PG8_SB(b, h) + boff + n * 2048 + k * 1024); } while (0)
#define PG8_MMA(ai, bj, At, Bt) do { __builtin_amdgcn_s_setprio(1); _Pragma("unroll") for (int m = 0; m < 4; ++m) _Pragma("unroll") for (int n = 0; n < 2; ++n) _Pragma("unroll") for (int k = 0; k < 2; ++k) \
        acc[ai][bj][m][n] = __builtin_amdgcn_mfma_f32_16x16x32_bf16(Bt[n][k], At[m][k], acc[ai][bj][m][n], 0, 0, 0); __builtin_amdgcn_s_setprio(0); } while (0)
#define PG8_WAIT_V(n) asm volatile("s_waitcnt vmcnt(" #n ")" ::: "memory")
#define PG8_WAIT_L(n) asm volatile("s_waitcnt lgkmcnt(" #n ")" ::: "memory")
#define PG8_BAR __builtin_amdgcn_s_barrier()
#define PG8_SCHED __builtin_amdgcn_sched_barrier(0)
    Unit cur, nxt; int ui = 0;
    if (!S.next(0, cur)) return;
    f32x4 acc[2][2][4][2];
#pragma unroll
    for (int a = 0; a < 2; ++a)
#pragma unroll
        for (int b = 0; b < 2; ++b)
#pragma unroll
            for (int m = 0; m < 4; ++m)
#pragma unroll
                for (int n = 0; n < 2; ++n) acc[a][b][m][n] = (f32x4){0.f, 0.f, 0.f, 0.f};
    bf16x8 At[4][2], B0[2][2], B1[2][2];
    const char* cA = (const char*)g.A + (size_t)cur.pm * tstep; const char* cB = (const char*)g.Bt + (size_t)cur.pn * tstep;
    S.a_ready(cur);
    if constexpr (SP2) {
        PG8_STAGE(PG8_SB(0, 0), cB, voffB); PG8_STAGE(PG8_SB(0, 1), cB + hstep, voffB); PG8_STAGE(PG8_SA(0, 0), cA, voffA); PG8_STAGE(PG8_SA(0, 1), cA + hstep, voffA);
        if (wr == 1) PG8_BAR;
        PG8_WAIT_V(2); PG8_BAR;
        PG8_STAGE(PG8_SB(1, 0), cB + kstep, voffB); PG8_STAGE(PG8_SA(1, 0), cA + kstep, voffA); PG8_STAGE(PG8_SB(1, 1), cB + hstep + kstep, voffB);
        PG8_WAIT_V(6); PG8_BAR;
    } else {
        PG8_STAGE(PG8_SB(0, 0), cB, voffB); PG8_STAGE(PG8_SA(0, 0), cA, voffA); PG8_STAGE(PG8_SB(0, 1), cB + hstep, voffB); PG8_STAGE(PG8_SA(0, 1), cA + hstep, voffA);
        if (wr == 1) PG8_BAR;
        PG8_WAIT_V(4); PG8_BAR;
        PG8_STAGE(PG8_SB(1, 0), cB + kstep, voffB); PG8_STAGE(PG8_SA(1, 0), cA + kstep, voffA); PG8_STAGE(PG8_SB(1, 1), cB + hstep + kstep, voffB);
        PG8_WAIT_V(6); PG8_BAR;
    }
    for (;;) {
        const bool has_next = S.next(ui + 1, nxt);
        const char* nA = has_next ? (const char*)g.A + (size_t)nxt.pm * tstep : cA; const char* nB = has_next ? (const char*)g.Bt + (size_t)nxt.pn * tstep : cB;
        for (int t = 0; t < nt; t += 2) {
            const bool last = (t == nt - 2);
            const char* a1 = cA + (size_t)(t + 1) * kstep;
            const char* a2 = last ? nA : cA + (size_t)(t + 2) * kstep; const char* b2 = last ? nB : cB + (size_t)(t + 2) * kstep;
            const char* a3 = a2 + kstep; const char* b3 = b2 + kstep;
            if (last && has_next) S.a_ready(nxt);
            if constexpr (SP2) {
            PG8_LDB(B0, 0, 0); PG8_LDB(B1, 0, 1); PG8_SCHED; PG8_LDA(At, 0, 0); PG8_STAGE(PG8_SA(1, 1), a1 + hstep, voffA);
            PG8_WAIT_V(8); PG8_WAIT_L(0); PG8_BAR; PG8_MMA(0, 0, At, B0); PG8_MMA(0, 1, At, B1); PG8_BAR; PG8_SCHED;
            PG8_LDA(At, 0, 1); PG8_STAGE(PG8_SB(0, 0), b2, voffB); PG8_STAGE(PG8_SB(0, 1), b2 + hstep, voffB); PG8_STAGE(PG8_SA(0, 0), a2, voffA);
            PG8_WAIT_V(8); PG8_WAIT_L(0); PG8_BAR; PG8_MMA(1, 0, At, B0); PG8_MMA(1, 1, At, B1); PG8_BAR; PG8_SCHED;
            PG8_LDB(B0, 1, 0); PG8_LDB(B1, 1, 1); PG8_SCHED; PG8_LDA(At, 1, 0); PG8_STAGE(PG8_SA(0, 1), a2 + hstep, voffA);
            PG8_WAIT_V(8); PG8_WAIT_L(0); PG8_BAR; PG8_MMA(0, 0, At, B0); PG8_MMA(0, 1, At, B1); PG8_BAR; PG8_SCHED;
            PG8_LDA(At, 1, 1); PG8_STAGE(PG8_SB(1, 0), b3, voffB); PG8_STAGE(PG8_SB(1, 1), b3 + hstep, voffB); PG8_STAGE(PG8_SA(1, 0), a3, voffA);
            PG8_WAIT_V(8); PG8_WAIT_L(0); PG8_BAR; PG8_MMA(1, 0, At, B0); PG8_MMA(1, 1, At, B1); PG8_BAR; PG8_SCHED;
            } else {
            PG8_LDB(B0, 0, 0); PG8_SCHED; PG8_LDA(At, 0, 0); PG8_STAGE(PG8_SA(1, 1), a1 + hstep, voffA);
            PG8_WAIT_L(8); PG8_BAR; PG8_WAIT_L(0); PG8_MMA(0, 0, At, B0); PG8_BAR; PG8_SCHED;
            PG8_LDB(B1, 0, 1); PG8_STAGE(PG8_SB(0, 0), b2, voffB);
            PG8_BAR; PG8_WAIT_L(0); PG8_MMA(0, 1, At, B1); PG8_BAR;
            PG8_LDA(At, 0, 1); PG8_STAGE(PG8_SA(0, 0), a2, voffA);
            PG8_BAR; PG8_WAIT_L(0); PG8_MMA(1, 0, At, B0); PG8_BAR; PG8_SCHED;
            PG8_STAGE(PG8_SB(0, 1), b2 + hstep, voffB);
            PG8_WAIT_V(6); PG8_BAR; PG8_MMA(1, 1, At, B1); PG8_BAR;
            PG8_LDB(B0, 1, 0); PG8_SCHED; PG8_LDA(At, 1, 0); PG8_STAGE(PG8_SA(0, 1), a2 + hstep, voffA);
            PG8_WAIT_L(8); PG8_BAR; PG8_WAIT_L(0); PG8_MMA(0, 0, At, B0); PG8_BAR; PG8_SCHED;
            PG8_LDB(B1, 1, 1); PG8_STAGE(PG8_SB(1, 0), b3, voffB);
            PG8_BAR; PG8_WAIT_L(0); PG8_MMA(0, 1, At, B1); PG8_BAR;
            PG8_LDA(At, 1, 1); PG8_STAGE(PG8_SA(1, 0), a3, voffA);
            PG8_BAR; PG8_WAIT_L(0); PG8_MMA(1, 0, At, B0); PG8_BAR; PG8_SCHED;
            PG8_STAGE(PG8_SB(1, 1), b3 + hstep, voffB);
            PG8_WAIT_V(6); PG8_BAR; PG8_MMA(1, 1, At, B1); PG8_BAR;
            }
        }
        if constexpr (ALIGN_EPI) { if (wr == 0) PG8_BAR; }
        if constexpr (!Epi::AFTER_DRAIN) { E(acc, cur, wr, wc, fr, fq); S.done(cur); }
        if (!has_next) break;
#pragma unroll
        for (int a = 0; a < 2; ++a)
#pragma unroll
            for (int b = 0; b < 2; ++b)
#pragma unroll
                for (int m = 0; m < 4; ++m)
#pragma unroll
                    for (int n = 0; n < 2; ++n) acc[a][b][m][n] = (f32x4){0.f, 0.f, 0.f, 0.f};
        cur = nxt; cA = nA; cB = nB; ++ui;
        if constexpr (ALIGN_EPI) { if (wr == 1) PG8_BAR; }
    }
    PG8_WAIT_V(0);
    if constexpr (!ALIGN_EPI) { if (wr == 0) PG8_BAR; }
    PG8_BAR;
    if constexpr (Epi::AFTER_DRAIN) { E.fused(acc, cur, wr, wc, fr, fq, lds, wid, lane); S.done(cur); }
#undef PG8_SA
#undef PG8_SB
#undef PG8_STAGE
#undef PG8_LDA
#undef PG8_LDB
#undef PG8_MMA
#undef PG8_WAIT_V
#undef PG8_WAIT_L
#undef PG8_BAR
#undef PG8_SCHED
}
}
namespace pg8 {
constexpr size_t EO_MiB = 1u << 20;
constexpr size_t EO_QM = 133 * EO_MiB, EO_KM = 166 * EO_MiB, EO_VM = 199 * EO_MiB, EO_GM = 232 * EO_MiB, EO_QA = 265 * EO_MiB, EO_SZA = 298 * EO_MiB, EO_SGM = 331 * EO_MiB, EO_SGA = 364 * EO_MiB, EO_KA = 397 * EO_MiB, EO_VA = 402 * EO_MiB;
constexpr size_t EO_KBP = 21241872, EO_VBP = 21372944, EO_KBS = 55124112, EO_VBS = 56172688;
__device__ __forceinline__ float sigmoid_f(float x) { return __builtin_amdgcn_rcpf(1.0f + __builtin_amdgcn_exp2f(-1.4426950408889634f * x)); }
__device__ __forceinline__ float bf_lo(unsigned w) { return __uint_as_float(w << 16); }
__device__ __forceinline__ float bf_hi(unsigned w) { return __uint_as_float(w & 0xffff0000u); }
struct EpiInProj {
    static constexpr bool PERM = true, AFTER_DRAIN = false;
    unsigned char* ws; float* out;
    __device__ __forceinline__ void operator()(const f32x4 (&acc)[2][2][4][2], const Unit& u, int wr, int wc, int fr, int fq) const {
        const int pn = u.pn, row0 = u.pm * BM + wr * 64 + fr, cl = wc * 32 + 8 * fq;
        if (pn >= 24 && pn < 40) {
            bf16_t* base = (bf16_t*)(ws + EO_GM) + (pn - 24) * 128 + cl;
#pragma unroll
            for (int ai = 0; ai < 2; ++ai)
#pragma unroll
                for (int m = 0; m < 4; ++m) {
                    const f32x4 o0 = acc[ai][0][m][0], o1 = acc[ai][0][m][1], z0 = acc[ai][1][m][0], z1 = acc[ai][1][m][1];
                    float g[8];
#pragma unroll
                    for (int e = 0; e < 4; ++e) { g[e] = sigmoid_f(o0[e]) * z0[e] * sigmoid_f(z0[e]); g[4 + e] = sigmoid_f(o1[e]) * z1[e] * sigmoid_f(z1[e]); }
                    u32x4 w; w.x = cvt_pk_bf16(g[0], g[1]); w.y = cvt_pk_bf16(g[2], g[3]); w.z = cvt_pk_bf16(g[4], g[5]); w.w = cvt_pk_bf16(g[6], g[7]);
                    *(u32x4*)(base + (size_t)(row0 + ai * HALF + m * 16) * 2048) = w;
                }
            return;
        }
        size_t doff; int ld = 2048, colt, mode = 0; float sc = 1.f;
        if (pn < 8) { doff = EO_QM; colt = pn * 256; sc = 0.04419417382415922f; }
        else if (pn < 16) { doff = EO_KM; colt = (pn - 8) * 256; }
        else if (pn < 24) { doff = EO_VM; colt = (pn - 16) * 256; }
        else if (pn < 48) { doff = EO_QA; colt = (pn - 40) * 256; sc = 0.125f; }
        else if (pn == 48) { doff = EO_KA; colt = 0; ld = 256; }
        else if (pn == 49) { doff = EO_VA; colt = 0; ld = 256; }
        else if (pn < 58) { doff = EO_SZA; colt = (pn - 50) * 256; mode = 1; }
        else if (pn < 66) { doff = EO_SGM; colt = (pn - 58) * 256; mode = 2; }
        else { doff = EO_SGA; colt = (pn - 66) * 256; mode = 2; }
#pragma unroll
        for (int ai = 0; ai < 2; ++ai)
#pragma unroll
            for (int m = 0; m < 4; ++m) {
                const int row = row0 + ai * HALF + m * 16;
#pragma unroll
                for (int bj = 0; bj < 2; ++bj) {
                    f32x4 v0 = acc[ai][bj][m][0] * sc, v1 = acc[ai][bj][m][1] * sc;
                    if (mode == 1) {
#pragma unroll
                        for (int e = 0; e < 4; ++e) { v0[e] = v0[e] * sigmoid_f(v0[e]); v1[e] = v1[e] * sigmoid_f(v1[e]); }
                    } else if (mode == 2) {
#pragma unroll
                        for (int e = 0; e < 4; ++e) { v0[e] = sigmoid_f(v0[e]); v1[e] = sigmoid_f(v1[e]); }
                    }
                    u32x4 w; w.x = cvt_pk_bf16(v0[0], v0[1]); w.y = cvt_pk_bf16(v0[2], v0[3]); w.z = cvt_pk_bf16(v1[0], v1[1]); w.w = cvt_pk_bf16(v1[2], v1[3]);
                    const int col = colt + bj * HALF + cl;
                    *(u32x4*)((bf16_t*)(ws + doff) + (size_t)row * ld + col) = w;
                    if (pn == 48 || pn == 49) {
                        float* o = nullptr;
                        if (row < 8192) { const int t = row & 2047; if (t >= 1920) o = (out + (pn == 48 ? EO_KBP : EO_VBP)) + ((size_t)((row >> 11) * 128 + (t - 1920)) * 256 + col); }
                        else if (row < 8320) { const int sr = row - 8192; o = (out + (pn == 48 ? EO_KBS : EO_VBS)) + ((size_t)((sr >> 2) * 128 + 124 + (sr & 3)) * 256 + col); }
                        if (o) { *(f32x4*)o = v0; *(f32x4*)(o + 4) = v1; }
                    }
                }
            }
    }
};
struct EpiPA {
    static constexpr bool PERM = true, AFTER_DRAIN = false;
    const bf16_t* SG; float* P;
    __device__ __forceinline__ void operator()(const f32x4 (&acc)[2][2][4][2], const Unit& u, int wr, int wc, int fr, int fq) const {
        const int row0 = u.pm * BM + wr * 64 + fr, col0 = u.pn * BM + wc * 32 + 8 * fq;
        u32x4 gn = *(const u32x4*)(SG + (size_t)row0 * 2048 + col0);
#pragma unroll
        for (int it = 0; it < 16; ++it) { const int ai = it >> 3, m = (it >> 1) & 3, bj = it & 1;
            const size_t off = (size_t)(row0 + ai * HALF + m * 16) * 2048 + col0 + bj * HALF;
            const u32x4 g = gn;
            if (it + 1 < 16) { const int a2 = (it + 1) >> 3, m2 = ((it + 1) >> 1) & 3, b2 = (it + 1) & 1; gn = *(const u32x4*)(SG + (size_t)(row0 + a2 * HALF + m2 * 16) * 2048 + col0 + b2 * HALF); }
            f32x4 v0 = acc[ai][bj][m][0], v1 = acc[ai][bj][m][1];
            v0[0] *= bf_lo(g.x); v0[1] *= bf_hi(g.x); v0[2] *= bf_lo(g.y); v0[3] *= bf_hi(g.y);
            v1[0] *= bf_lo(g.z); v1[1] *= bf_hi(g.z); v1[2] *= bf_lo(g.w); v1[3] *= bf_hi(g.w);
            *(f32x4*)(P + off) = v0; *(f32x4*)(P + off + 4) = v1; }
    }
};
struct EpiY {
    static constexpr bool PERM = true, AFTER_DRAIN = false;
    const bf16_t* SG; const float* P; bf16_t* Y;
    __device__ __forceinline__ void operator()(const f32x4 (&acc)[2][2][4][2], const Unit& u, int wr, int wc, int fr, int fq) const {
        const int row0 = u.pm * BM + wr * 64 + fr, col0 = u.pn * BM + wc * 32 + 8 * fq;
        const size_t off0 = (size_t)row0 * 2048 + col0;
        u32x4 gn = *(const u32x4*)(SG + off0); f32x4 pn0 = *(const f32x4*)(P + off0), pn1 = *(const f32x4*)(P + off0 + 4);
#pragma unroll
        for (int it = 0; it < 16; ++it) { const int ai = it >> 3, m = (it >> 1) & 3, bj = it & 1;
            const size_t off = (size_t)(row0 + ai * HALF + m * 16) * 2048 + col0 + bj * HALF;
            const u32x4 g = gn; const f32x4 p0 = pn0, p1 = pn1;
            if (it + 1 < 16) { const int a2 = (it + 1) >> 3, m2 = ((it + 1) >> 1) & 3, b2 = (it + 1) & 1; const size_t o2 = (size_t)(row0 + a2 * HALF + m2 * 16) * 2048 + col0 + b2 * HALF;
                gn = *(const u32x4*)(SG + o2); pn0 = *(const f32x4*)(P + o2); pn1 = *(const f32x4*)(P + o2 + 4); }
            f32x4 v0 = acc[ai][bj][m][0], v1 = acc[ai][bj][m][1];
            v0[0] = v0[0] * bf_lo(g.x) + p0[0]; v0[1] = v0[1] * bf_hi(g.x) + p0[1]; v0[2] = v0[2] * bf_lo(g.y) + p0[2]; v0[3] = v0[3] * bf_hi(g.y) + p0[3];
            v1[0] = v1[0] * bf_lo(g.z) + p1[0]; v1[1] = v1[1] * bf_hi(g.z) + p1[1]; v1[2] = v1[2] * bf_lo(g.w) + p1[2]; v1[3] = v1[3] * bf_hi(g.w) + p1[3];
            u32x4 w; w.x = cvt_pk_bf16(v0[0], v0[1]); w.y = cvt_pk_bf16(v0[2], v0[3]); w.z = cvt_pk_bf16(v1[0], v1[1]); w.w = cvt_pk_bf16(v1[2], v1[3]);
            *(u32x4*)(Y + off) = w; }
    }
};
struct EpiOut {
    static constexpr bool PERM = true, AFTER_DRAIN = false;
    const float* xp; float* out; float alpha;
    __device__ __forceinline__ void operator()(const f32x4 (&acc)[2][2][4][2], const Unit& u, int wr, int wc, int fr, int fq) const {
        const int row0 = u.pm * BM + wr * 64 + fr, col0 = u.pn * BM + wc * 32 + 8 * fq;
        const size_t off0 = (size_t)row0 * 2048 + col0;
        f32x4 xn0 = *(const f32x4*)(xp + off0), xn1 = *(const f32x4*)(xp + off0 + 4);
#pragma unroll
        for (int it = 0; it < 16; ++it) { const int ai = it >> 3, m = (it >> 1) & 3, bj = it & 1;
            const size_t off = (size_t)(row0 + ai * HALF + m * 16) * 2048 + col0 + bj * HALF;
            const f32x4 x0 = xn0, x1 = xn1;
            if (it + 1 < 16) { const int a2 = (it + 1) >> 3, m2 = ((it + 1) >> 1) & 3, b2 = (it + 1) & 1; const size_t o2 = (size_t)(row0 + a2 * HALF + m2 * 16) * 2048 + col0 + b2 * HALF;
                xn0 = *(const f32x4*)(xp + o2); xn1 = *(const f32x4*)(xp + o2 + 4); }
            *(f32x4*)(out + off) = x0 * alpha + acc[ai][bj][m][0]; *(f32x4*)(out + off + 4) = x1 * alpha + acc[ai][bj][m][1]; }
    }
};
}
#define GAS __attribute__((address_space(1)))
#define LAS __attribute__((address_space(3)))
typedef unsigned short bf16;
typedef unsigned v4u __attribute__((ext_vector_type(4)));
typedef float f32x4 __attribute__((ext_vector_type(4)));
typedef short bf16x8 __attribute__((ext_vector_type(8)));
typedef GAS unsigned gu32;
typedef GAS unsigned long long gu64;
#define RLX_AGENT __ATOMIC_RELAXED, __HIP_MEMORY_SCOPE_AGENT
#define LDS_WAIT() asm volatile("s_waitcnt lgkmcnt(0)" ::: "memory")
#define VM_WAIT() asm volatile("s_waitcnt vmcnt(0)" ::: "memory")
__device__ __forceinline__ unsigned long long rt() { return __builtin_amdgcn_s_memrealtime(); }
__device__ __forceinline__ unsigned f2bf(float f) { unsigned u = __builtin_bit_cast(unsigned, f); return (u + 0x7fffu + ((u >> 16) & 1u)) >> 16; }
__device__ __forceinline__ unsigned pk2(float lo, float hi) { return f2bf(lo) | (f2bf(hi) << 16); }

#define XB_TMO      128
#define XB_XCNT(j)  (256  + 64 * (j))
#define XB_XSUB(j)  (1280 + 64 * (j))
#define XB_XGEN(j)  (2304 + 64 * (j))
#define XB_TOP      3328
#define XB_TOPGEN   3392
#define XCD_BAR_WORDS 3456
#define XB_SPIN_CAP (1u << 18)

__device__ __forceinline__ unsigned xb_ld(unsigned* p)              { return __hip_atomic_load(p, __ATOMIC_RELAXED, __HIP_MEMORY_SCOPE_AGENT); }
__device__ __forceinline__ unsigned xb_add(unsigned* p, unsigned v) { return __hip_atomic_fetch_add(p, v, __ATOMIC_RELAXED, __HIP_MEMORY_SCOPE_AGENT); }
__device__ __forceinline__ unsigned xb_xcc_id() { return (unsigned)__builtin_amdgcn_s_getreg((3 << 11) | 20) & 0xFu; }
#define XB_SPIN(cond, bar) do { unsigned _sp = 0; while (cond) { __builtin_amdgcn_s_sleep(1); \
    if ((++_sp & 255u) == 0u) { if (xb_ld(&(bar)[XB_TMO])) break; if (_sp > XB_SPIN_CAP) { atomicAdd(&(bar)[XB_TMO], 1u); break; } } } } while (0)

struct XcdBarrier {
    unsigned* bar; unsigned x;
    volatile LAS unsigned* st;
};

__device__ __forceinline__ XcdBarrier xcd_barrier_post(unsigned* bar, volatile LAS unsigned* st) {
    XcdBarrier b; b.bar = bar; b.x = xb_xcc_id(); b.st = st;
    if (threadIdx.x == 0) (void)xb_add(&bar[XB_XCNT(b.x)], 1u);
    return b;
}
__device__ __forceinline__ void xcd_barrier_complete(unsigned* bar, unsigned x, unsigned& nloc, unsigned& nx) {
    const unsigned G = gridDim.x * gridDim.y * gridDim.z;
    unsigned sum, cnt, mine, sp = 0u;
    for (;;) {
        sum = 0u; cnt = 0u; mine = 0u;
#pragma unroll
        for (unsigned j = 0; j < 16; ++j) { const unsigned c = xb_ld(&bar[XB_XCNT(j)]); sum += c; cnt += (c > 0u) ? 1u : 0u; mine = (j == x) ? c : mine; }
        if (sum == G) break;
        __builtin_amdgcn_s_sleep(1);
        if ((++sp & 255u) == 0u) { if (xb_ld(&bar[XB_TMO])) break; if (sp > XB_SPIN_CAP) { atomicAdd(&bar[XB_TMO], 1u); break; } }
    }
    nloc = mine > 0u ? mine : 1u; nx = cnt > 0u ? cnt : 1u;
}

__device__ __forceinline__ void xcd_barrier(const XcdBarrier& b) {
    asm volatile("s_waitcnt vmcnt(0)" ::: "memory");
    __syncthreads();
    if (threadIdx.x == 0) {
        unsigned* bar = b.bar;
        __builtin_amdgcn_s_waitcnt(0);
        unsigned nloc = b.st[0], nx = b.st[1];
        if (nloc == 0u) { xcd_barrier_complete(bar, b.x, nloc, nx); b.st[0] = nloc; b.st[1] = nx; }
        const unsigned old = xb_add(&bar[XB_XSUB(b.x)], 1u);
        const unsigned gen = old / nloc;
        if (old + 1u == (gen + 1u) * nloc) {
            __builtin_amdgcn_fence(__ATOMIC_RELEASE, "agent");
            asm volatile("s_waitcnt vmcnt(0)" ::: "memory");
            const unsigned og = xb_add(&bar[XB_TOP], 1u);
            const unsigned tg = og / nx;
            if (og + 1u == (tg + 1u) * nx) xb_add(&bar[XB_TOPGEN], 1u);
            else XB_SPIN(xb_ld(&bar[XB_TOPGEN]) == tg, bar);
            __builtin_amdgcn_fence(__ATOMIC_ACQUIRE, "agent");
            xb_add(&bar[XB_XGEN(b.x)], 1u);
            asm volatile("s_waitcnt vmcnt(0)" ::: "memory");
        } else {
            XB_SPIN(xb_ld(&bar[XB_XGEN(b.x)]) == gen, bar);
            __builtin_amdgcn_fence(__ATOMIC_ACQUIRE, "agent");
            asm volatile("s_waitcnt vmcnt(0)" ::: "memory");
        }
    }
    __syncthreads();
}
constexpr int DM = 2048, NTP = 8192, NTS = 128, NTOK = NTP + NTS, MPAD = 8448;
constexpr int LDW = 18952, NIN = 18944;
constexpr int SEQ = 2048, NB = 4, SB = 32, ST = 4, MH = 4, DH = 512;
constexpr float LN_EPS = 1e-5f, DN_ALPHA = 1.189207115002721f, QM_SCALE = 0.04419417382415922f, QA_SCALE = 0.125f;
constexpr size_t O_YP = 0, O_YS = 16777216, O_CP = 17039360, O_NP = 21233664, O_MP = 21241856, O_KBP = 21241872, O_VBP = 21372944,
                 O_CS = 21504016, O_NS = 55058448, O_MS = 55123984, O_KBS = 55124112, O_VBS = 56172688, O_END = 57221264;
constexpr size_t MiB = 1u << 20;
constexpr size_t WS_CTL = 0, CTL_ZERO_BYTES = 1 * MiB;
constexpr size_t WS_WIN = 2 * MiB, WS_P = 2 * MiB  , WS_WPM = 76 * MiB, WS_WPA = 84 * MiB, WS_WOUT = 92 * MiB;
constexpr size_t WS_XB = 100 * MiB, WS_Y = 100 * MiB  ;
constexpr size_t WS_QM = 133 * MiB, WS_KM = 166 * MiB, WS_VM = 199 * MiB, WS_GM = 232 * MiB, WS_QA = 265 * MiB, WS_SZA = 298 * MiB, WS_SGM = 331 * MiB, WS_SGA = 364 * MiB;
constexpr size_t WS_KA = 397 * MiB, WS_VA = 402 * MiB, WS_HM = 407 * MiB, WS_BRM = 473 * MiB, WS_BRA = 506 * MiB, WS_IG = 539 * MiB, WS_LF = 540 * MiB, WS_GT = 541 * MiB  , WS_SD = 543 * MiB  , WS_END = 548 * MiB;
constexpr int CW_BAR = 4096;
constexpr int NWAVES = 8;
constexpr int RING_OFF = 0, RING_BYTES = 131072, LDS_BYTES = 163840, LDSCTL_OFF = LDS_BYTES - 256, MISC_OFF = LDSCTL_OFF;
struct Frame {
    LAS unsigned char* lds; unsigned char* ldsg;
    volatile LAS unsigned* MISC; gu32* ctl;
    int tid, lane, wave, vcu, G;
    unsigned char* ws; float* out;
};
#define WSB(off) ((bf16*)(F.ws + (off)))
#define WSF(off) ((float*)(F.ws + (off)))
__device__ __forceinline__ float wave_sum(float v) {
#pragma unroll
    for (int o = 1; o < 64; o <<= 1) v += __shfl_xor(v, o);
    return v;
}
__device__ __forceinline__ float wave_max(float v) {
#pragma unroll
    for (int o = 1; o < 64; o <<= 1) v = fmaxf(v, __shfl_xor(v, o));
    return v;
}
__device__ __forceinline__ float bf2f(bf16 h) { return __uint_as_float((unsigned)h << 16); }
__device__ __forceinline__ float bflo(unsigned w) { return __uint_as_float(w << 16); }
__device__ __forceinline__ float bfhi(unsigned w) { return __uint_as_float(w & 0xffff0000u); }
__device__ __forceinline__ float log_sigmoid_f(float x) { return x >= 0.f ? -log1pf(expf(-x)) : x - log1pf(expf(x)); }

__device__ __forceinline__ void p0_transpose_tile(const float* W, int ldw, int srccol, int k0, bf16* WT, int K, int dstrow, LAS float* scr, int lane) {
    const int kr = lane >> 4, nc = lane & 15;
    f32x4 v[16];
#pragma unroll
    for (int i = 0; i < 16; ++i) v[i] = *(const f32x4*)(W + (size_t)(k0 + 4 * i + kr) * ldw + srccol + 4 * nc);
#pragma unroll
    for (int i = 0; i < 16; ++i) { LAS float* d = scr + (4 * i + kr) * 65 + 4 * nc; d[0] = v[i][0]; d[1] = v[i][1]; d[2] = v[i][2]; d[3] = v[i][3]; }
    LDS_WAIT(); asm volatile("" ::: "memory");
    const int c = lane & 7;
#pragma unroll
    for (int j = 0; j < 8; ++j) { const int n = (lane >> 3) + 8 * j; const LAS float* s = scr + (8 * c) * 65 + n;
        v4u o; o.x = pk2(s[0 * 65], s[1 * 65]); o.y = pk2(s[2 * 65], s[3 * 65]); o.z = pk2(s[4 * 65], s[5 * 65]); o.w = pk2(s[6 * 65], s[7 * 65]);
        *(GAS v4u*)(WT + (size_t)(dstrow + n) * K + k0 + 8 * c) = o; }
    LDS_WAIT(); asm volatile("" ::: "memory");
}
__device__ __forceinline__ int win_src_col(int vn) {
    if (vn < 6144 || vn >= 10240) return vn;
    const int j = (vn - 6144) >> 8, i = (vn - 6144) & 255;
    return i < 128 ? 6144 + 128 * j + i : 8192 + 128 * j + (i - 128);
}
__device__ __forceinline__ void p0_prologue(Frame& F, const float* xp, const float* xs, const float* w_in, const float* wpm, const float* wpa, const float* wout, const float* b_i, const float* b_f, const float* sk, const float* sv) {
    const int gw = F.vcu * NWAVES + F.wave, NGW = F.G * NWAVES, lane = F.lane;
    {
        LAS float* scr = (LAS float*)(F.lds + RING_OFF + F.wave * 16640);
        constexpr int I_IN = 32 * (NIN / 64), I_SQ = 32 * 32, NITEMS = I_IN + 3 * I_SQ;
        for (int it = gw; it < NITEMS; it += NGW) {
            int r = it;
            if (r < I_IN) { const int kb = r / (NIN / 64), nb = r % (NIN / 64); p0_transpose_tile(w_in, LDW, win_src_col(64 * nb), 64 * kb, WSB(WS_WIN), DM, 64 * nb, scr, lane); continue; }
            r -= I_IN;
            const int which = r / I_SQ; r %= I_SQ; const int kb = r / 32, nb = r % 32;
            const float* W = which == 0 ? wpm : (which == 1 ? wpa : wout); bf16* WT = which == 0 ? WSB(WS_WPM) : (which == 1 ? WSB(WS_WPA) : WSB(WS_WOUT));
            p0_transpose_tile(W, DM, 64 * nb, 64 * kb, WT, DM, 64 * nb, scr, lane);
        }
    }
    __syncthreads();
    {
        LAS float* W8 = (LAS float*)(F.lds + RING_OFF);
        {
            f32x4 t_[8];
#pragma unroll
            for (int ps = 0; ps < 1; ++ps) {
#pragma unroll
                for (int i = 0; i < 8; ++i) { const int idx = F.tid + 512 * i; const int k = idx >> 1, hf = idx & 1; t_[i] = *(const f32x4*)(w_in + (size_t)k * LDW + NIN + 4 * hf); }
#pragma unroll
                for (int i = 0; i < 8; ++i) { const int idx = F.tid + 512 * i; const int k = idx >> 1, hf = idx & 1; *(LAS f32x4*)(W8 + (((k >> 8) * 4 + (k & 3)) * 64 + ((k >> 2) & 63)) * 8 + 4 * hf) = t_[i]; }
            }
        }
        __syncthreads();
        for (int r = gw; r < MPAD; r += NGW) {
            f32x4 v[8];
            if (r < NTOK) { const GAS f32x4* xr = (const GAS f32x4*)(r < NTP ? xp + (size_t)r * DM : xs + (size_t)(r - NTP) * DM) + lane;
#pragma unroll
                for (int j = 0; j < 8; ++j) v[j] = xr[64 * j]; }
            else {
#pragma unroll
                for (int j = 0; j < 8; ++j) v[j] = (f32x4){0.f, 0.f, 0.f, 0.f}; }
            GAS unsigned long long* o8 = (GAS unsigned long long*)(WSB(WS_XB) + (size_t)r * DM) + lane;
#pragma unroll
            for (int j = 0; j < 8; ++j) o8[64 * j] = (unsigned long long)pk2(v[j].x, v[j].y) | ((unsigned long long)pk2(v[j].z, v[j].w) << 32);
            if (r < NTOK) {
                float a[8];
#pragma unroll
                for (int c = 0; c < 8; ++c) a[c] = 0.f;
#pragma unroll
                for (int j = 0; j < 8; ++j)
#pragma unroll
                    for (int e = 0; e < 4; ++e) { const LAS f32x4* wp = (const LAS f32x4*)(W8 + ((j * 4 + e) * 64 + lane) * 8); const f32x4 w0 = wp[0], w1 = wp[1]; const float xv = v[j][e];
                        a[0] += xv * w0[0]; a[1] += xv * w0[1]; a[2] += xv * w0[2]; a[3] += xv * w0[3]; a[4] += xv * w1[0]; a[5] += xv * w1[1]; a[6] += xv * w1[2]; a[7] += xv * w1[3]; }
#pragma unroll
                for (int c = 0; c < 8; ++c) a[c] = wave_sum(a[c]);
                if (lane < 8) {
                    const float s = lane == 0 ? a[0] : lane == 1 ? a[1] : lane == 2 ? a[2] : lane == 3 ? a[3] : lane == 4 ? a[4] : lane == 5 ? a[5] : lane == 6 ? a[6] : a[7];
                    if (lane < 4) WSF(WS_IG)[(size_t)r * 4 + lane] = s + b_i[lane];
                    else WSF(WS_LF)[(size_t)r * 4 + (lane - 4)] = log_sigmoid_f(s + b_f[lane - 4]);
                }
            }
        }
    }
    {
        const int gt = F.vcu * (NWAVES * 64) + F.tid, NGT = F.G * NWAVES * 64;
        const f32x4* sk4 = (const f32x4*)sk; const f32x4* sv4 = (const f32x4*)sv; f32x4* kb4 = (f32x4*)(F.out + O_KBS); f32x4* vb4 = (f32x4*)(F.out + O_VBS);
        for (int i = gt; i < SB * 124 * 64; i += NGT) { const int b = i / (124 * 64), rem = i % (124 * 64);
            kb4[(size_t)b * 128 * 64 + rem] = sk4[(size_t)b * 128 * 64 + 4 * 64 + rem]; vb4[(size_t)b * 128 * 64 + rem] = sv4[(size_t)b * 128 * 64 + 4 * 64 + rem]; }
        v4u* z = (v4u*)(WSB(WS_BRA) + (size_t)NTOK * DM);
        for (int i = gt; i < (MPAD - NTOK) * DM / 8; i += NGT) z[i] = (v4u){0u, 0u, 0u, 0u};
    }
}
namespace ml {
typedef short bf16x8 __attribute__((ext_vector_type(8)));
typedef short s16x4 __attribute__((ext_vector_type(4)));
typedef float f32x4 __attribute__((ext_vector_type(4)));
typedef float f32x2 __attribute__((ext_vector_type(2)));
typedef __bf16 bf16x2_t __attribute__((ext_vector_type(2)));
constexpr int SLOTB = 65536, L_RING = 0, L_VT = 131072, VROWS = 34, L_VWT = L_VT + VROWS * 128, L_SD = L_VWT + VROWS * 128, L_PDEN = L_SD + 8192,
              L_VRAW = L_PDEN + 2048, L_TB = L_VRAW + 4096, TBB = 2048, L_END = L_TB + 2 * TBB;
static_assert(L_END <= 163840 - 256, "mLSTM LDS map");
constexpr size_t GT_CHUNK = 6 * 64;
__device__ __forceinline__ unsigned cvtpk(float lo, float hi) { f32x2 v = {lo, hi}; bf16x2_t b = __builtin_convertvector(v, bf16x2_t); return __builtin_bit_cast(unsigned, b); }
__device__ __forceinline__ int xsw(int row) { return ((row & 3) << 2) | ((row >> 2) & 3); }
__device__ __forceinline__ int imgoff(int row, int ch) { return 256 * row + 16 * (ch ^ xsw(row)); }
__device__ __forceinline__ int voff(int row, int s) { return row * 128 + 16 * ((s >> 3) ^ (row & 7)) + (s & 7) * 2; }
__device__ __forceinline__ void glds16(const void* g, LAS unsigned char* l) { __builtin_amdgcn_global_load_lds((const unsigned*)g, (LAS unsigned*)l, 16, 0, 0); }
__device__ __forceinline__ s16x4 trrd(LAS unsigned char* p) { typedef short v4i16_t __attribute__((ext_vector_type(4))); return __builtin_bit_cast(s16x4, __builtin_amdgcn_ds_read_tr16_b64_v4i16((LAS v4i16_t*)p)); }
#define ML_MFMA(a, b, c) __builtin_amdgcn_mfma_f32_16x16x32_bf16((a), (b), (c), 0, 0, 0)
#define ML_VMWAIT() asm volatile("s_waitcnt vmcnt(0)" ::: "memory")

__device__ __forceinline__ void gate_scan(Frame& F, int bh, int lane) {
    const int b = bh >> 2, h = bh & 3; float m = 0.f;
    float* gt = WSF(WS_GT) + (size_t)bh * 32 * GT_CHUNK;
    for (int c = 0; c < 32; ++c) {
        const size_t r = (size_t)(b * SEQ + c * 64 + lane);
        const float ig = WSF(WS_IG)[r * 4 + h], lf = WSF(WS_LF)[r * 4 + h];
        float bcs = lf;
#pragma unroll
        for (int o = 1; o < 64; o <<= 1) { const float t_ = __shfl_up(bcs, o); if (lane >= o) bcs += t_; }
        const float av = ig - bcs; float pm = av;
#pragma unroll
        for (int o = 1; o < 64; o <<= 1) { const float t_ = __shfl_up(pm, o); if (lane >= o) pm = fmaxf(pm, t_); }
        const float mrow = bcs + fmaxf(pm, m);
        const float blast = __shfl(bcs, 63), mnew = blast + fmaxf(m, __shfl(pm, 63));
        float* g = gt + (size_t)c * GT_CHUNK;
        g[lane] = bcs - mrow; g[64 + lane] = av; g[128 + lane] = expf(bcs + m - mrow); g[192 + lane] = expf(blast + av - mnew); g[256 + lane] = expf(-mrow);
        g[320 + lane] = lane == 0 ? expf(blast + m - mnew) : 0.f;
        m = mnew;
    }
    if (lane == 0) F.out[O_MP + bh] = m;
}

__device__ __forceinline__ void sd_task(Frame& F, int bh, int c) {
    LAS unsigned char* L = F.lds;
    const int lane0 = F.lane, w = F.wave, b = bh >> 2, h = bh & 3, r0 = b * SEQ + c * 64;
    const char* Qg = (const char*)WSB(WS_QM) + ((size_t)r0 * DM + h * 512) * 2;
    const char* Kg = (const char*)WSB(WS_KM) + ((size_t)r0 * DM + h * 512) * 2;
    const unsigned srcbase = (unsigned)((32 * (w & 1) + (lane0 >> 4)) * (DM * 2) + ((w >> 1) & 1) * 256); const int cbx = (lane0 & 15) ^ ((lane0 >> 4) << 2);
    const char* QKg = (w < 4) ? Qg : Kg;
    const int dstbase = ((8 * w) >> 5) * 32768 + (((8 * w) >> 4) & 1) * 16384 + ((8 * w) & 15) * 1024;
#pragma unroll
    for (int hf = 0; hf < 2; ++hf)
#pragma unroll
        for (int i = 0; i < 8; ++i) glds16(QKg + hf * 512 + srcbase + (unsigned)(i * 4 * (DM * 2)) + (unsigned)((cbx ^ (i & 3)) << 4), L + L_RING + hf * SLOTB + dstbase + i * 1024);
    int lane = lane0; asm volatile("" : "+v"(lane));
    const int l15 = lane & 15, q = lane >> 4, tt = w >> 1, sp = w & 1;
    const float* g = WSF(WS_GT) + ((size_t)bh * 32 + c) * GT_CHUNK;
    const int s0 = 32 * sp + l15, s1 = s0 + 16; const float a0 = g[64 + s0], a1 = g[64 + s1];
    const f32x4 re = *(const f32x4*)(g + 16 * tt + 4 * q);
    ML_VMWAIT(); __syncthreads();
    f32x4 S0 = (f32x4){0.f, 0.f, 0.f, 0.f}, S1 = S0;
    if (2 * sp <= tt) {
#pragma unroll
        for (int hf = 0; hf < 2; ++hf) { LAS unsigned char* Qs = L + L_RING + hf * SLOTB; LAS unsigned char* Ks = Qs + 32768;
#pragma unroll 4
            for (int ks = 0; ks < 8; ++ks) { const int kc = ks >> 2, ch = 4 * (ks & 3) + q;
                const bf16x8 a = *(const LAS bf16x8*)(Qs + kc * 16384 + imgoff(16 * tt + l15, ch));
                const bf16x8 b0 = *(const LAS bf16x8*)(Ks + kc * 16384 + imgoff(32 * sp + l15, ch));
                S0 = ML_MFMA(a, b0, S0);
                if (2 * sp + 1 <= tt) { const bf16x8 b1 = *(const LAS bf16x8*)(Ks + kc * 16384 + imgoff(32 * sp + 16 + l15, ch)); S1 = ML_MFMA(a, b1, S1); } } }
    }
    bf16* sd = WSB(WS_SD) + ((size_t)bh * 32 + c) * 4096;
#pragma unroll
    for (int r = 0; r < 4; ++r) { const int t = 16 * tt + 4 * q + r;
        const float d0 = s0 <= t ? S0[r] * __expf(re[r] + a0) : 0.f, d1 = s1 <= t ? S1[r] * __expf(re[r] + a1) : 0.f;
        sd[t * 64 + s0] = (bf16)(cvtpk(d0, 0.f) & 0xffffu); sd[t * 64 + s1] = (bf16)(cvtpk(d1, 0.f) & 0xffffu); }
    __syncthreads();
}

__device__ __forceinline__ void mlstm_job(Frame& F, int bh, int vs, float* Cout, float* nout) {
    LAS unsigned char* L = F.lds;
#ifdef TPROBE
    const unsigned long long tp_job0 = __builtin_amdgcn_s_memtime(); unsigned long long tp_acc = 0, tp_t0 = 0;
#define TP_BEGIN(id) do { if (TPROBE == (id)) { __builtin_amdgcn_sched_barrier(0); tp_t0 = __builtin_amdgcn_s_memtime(); __builtin_amdgcn_sched_barrier(0); } } while (0)
#define TP_END(id) do { if (TPROBE == (id)) { __builtin_amdgcn_sched_barrier(0); tp_acc += __builtin_amdgcn_s_memtime() - tp_t0; __builtin_amdgcn_sched_barrier(0); } } while (0)
#else
#define TP_BEGIN(id)
#define TP_END(id)
#endif
    const int tid = F.tid, lane0 = F.lane, w = F.wave, b = bh >> 2, h = bh & 3, r0 = b * SEQ;
    const char* Qg = (const char*)WSB(WS_QM) + ((size_t)r0 * DM + h * 512) * 2;
    const char* Kg = (const char*)WSB(WS_KM) + ((size_t)r0 * DM + h * 512) * 2;
    const char* Vg = (const char*)WSB(WS_VM) + ((size_t)r0 * DM + h * 512 + vs * 32) * 2;
    const char* SDg = (const char*)(WSB(WS_SD) + (size_t)bh * 32 * 4096);
    const char* GTg = (const char*)(WSF(WS_GT) + (size_t)bh * 32 * GT_CHUNK);
    float* Hg = WSF(WS_HM) + (size_t)r0 * DM + h * 512 + vs * 32;
    const unsigned srcbase = (unsigned)((32 * (w & 1) + (lane0 >> 4)) * (DM * 2) + ((w >> 1) & 1) * 256); const int cbx = (lane0 & 15) ^ ((lane0 >> 4) << 2);
#define ML_SRCOFF(i_) (srcbase + (unsigned)((i_) * 4 * (DM * 2)) + (unsigned)((cbx ^ ((i_) & 3)) << 4))
    const char* QKg = (w < 4) ? Qg : Kg;
    const int dstbase = ((8 * w) >> 5) * 32768 + (((8 * w) >> 4) & 1) * 16384 + ((8 * w) & 15) * 1024;
#define ML_DMA_SLOT(step_) do { const int st_ = (step_); const char* g_ = QKg + (size_t)(st_ >> 1) * (64 * DM * 2) + (st_ & 1) * 512; LAS unsigned char* d_ = L + L_RING + (st_ & 1) * SLOTB + dstbase; \
        _Pragma("unroll") for (int i_ = 0; i_ < 8; ++i_) glds16(g_ + ML_SRCOFF(i_), d_ + i_ * 1024); } while (0)
#define ML_DMA_VT(c_) do { const int cc_ = (c_); if (w < 4) glds16(Vg + (size_t)(cc_ * 64 + 16 * w + (lane0 >> 2)) * (DM * 2) + (lane0 & 3) * 16, L + L_VRAW + w * 1024); \
        else if (w < 6) glds16(GTg + (size_t)cc_ * (GT_CHUNK * 4) + (w - 4) * 1024 + lane0 * 16, L + L_TB + (cc_ & 1) * TBB + (w - 4) * 1024); } while (0)
#define ML_DMA_SD(c_) glds16(SDg + (size_t)(c_) * 8192 + (8 * w + (lane0 >> 3)) * 128 + (((lane0 & 7) ^ ((lane0 >> 3) & 7)) << 4), L + L_SD + w * 1024)
    if (tid < 64) { *(LAS unsigned short*)(L + L_VT + voff(32, tid)) = 0x3F80; *(LAS unsigned short*)(L + L_VT + voff(33, tid)) = 0; *(LAS unsigned short*)(L + L_VWT + voff(33, tid)) = 0; }
    f32x4 C[2][2][3];
#pragma unroll
    for (int a = 0; a < 2; ++a)
#pragma unroll
        for (int bb = 0; bb < 2; ++bb)
#pragma unroll
            for (int cc = 0; cc < 3; ++cc) C[a][bb][cc] = (f32x4){0.f, 0.f, 0.f, 0.f};
    const int nchunk = 32;
    ML_DMA_SLOT(0); ML_DMA_VT(0); ML_DMA_SD(0);
    ML_VMWAIT(); __syncthreads();
    const int tt = w >> 1, sp = w & 1;
    const int kcw = w >> 2, chw = 4 * (w & 3);
    for (int c = 0; c < nchunk; ++c) {
        int lane = lane0; asm volatile("" : "+v"(lane));
        const int l15 = lane & 15, q = lane >> 4; const int tidc = w * 64 + lane;
        LAS float* TB = (LAS float*)(L + L_TB + (c & 1) * TBB);
        TP_BEGIN(1);
        if (w < 4) {
            const int s = 16 * w + (lane >> 2), part = lane & 3; const float ws = TB[192 + s];
            const v4u raw = *(const LAS v4u*)(L + L_VRAW + s * 64 + part * 16);
            const unsigned rw[4] = {raw.x, raw.y, raw.z, raw.w};
#pragma unroll
            for (int e = 0; e < 4; ++e) { const int v0 = 8 * part + 2 * e;
                *(LAS unsigned short*)(L + L_VT + voff(v0, s)) = (unsigned short)(rw[e] & 0xffffu); *(LAS unsigned short*)(L + L_VT + voff(v0 + 1, s)) = (unsigned short)(rw[e] >> 16);
                const unsigned pw = cvtpk(bflo(rw[e]) * ws, bfhi(rw[e]) * ws);
                *(LAS unsigned short*)(L + L_VWT + voff(v0, s)) = (unsigned short)(pw & 0xffffu); *(LAS unsigned short*)(L + L_VWT + voff(v0 + 1, s)) = (unsigned short)(pw >> 16); }
        } else if (w == 4) { *(LAS unsigned short*)(L + L_VWT + voff(32, lane)) = (unsigned short)(cvtpk(TB[192 + lane], 0.f) & 0xffffu); }
        const float decay = TB[320];
        f32x4 G[4][3];
#pragma unroll
        for (int a = 0; a < 4; ++a)
#pragma unroll
            for (int bb = 0; bb < 3; ++bb) G[a][bb] = (f32x4){0.f, 0.f, 0.f, 0.f};
        TP_END(1);
#pragma unroll
        for (int hf = 0; hf < 2; ++hf) {
            const int step = 2 * c + hf;
            TP_BEGIN(7); if (step + 1 < 2 * nchunk) ML_DMA_SLOT(step + 1); TP_END(7);
            TP_BEGIN(2);
            int lq_ = lane0; asm volatile("" : "+v"(lq_));
            const int l15 = lq_ & 15, q = lq_ >> 4;
            LAS unsigned char* Qs = L + L_RING + (step & 1) * SLOTB; LAS unsigned char* Ks = Qs + 32768;
            bf16x8 qa[4], ka[2][2];
#pragma unroll
            for (int t4 = 0; t4 < 4; ++t4) { const int row = 16 * t4 + l15;
                const s16x4 lo = *(const LAS s16x4*)(Qs + kcw * 16384 + imgoff(row, chw + (q >> 1)) + 8 * (q & 1));
                const s16x4 hi = *(const LAS s16x4*)(Qs + kcw * 16384 + imgoff(row, chw + 2 + (q >> 1)) + 8 * (q & 1));
                qa[t4] = __builtin_shufflevector(lo, hi, 0, 1, 2, 3, 4, 5, 6, 7); }
#pragma unroll
            for (int ss = 0; ss < 2; ++ss)
#pragma unroll
                for (int kt = 0; kt < 2; ++kt) { const int cc = 2 * (w & 3) + kt, qq = l15 >> 2, p = lq_ & 3;
                    const s16x4 lo = trrd(Ks + kcw * 16384 + imgoff(32 * ss + 8 * q + qq, 2 * cc + (p >> 1)) + 8 * (p & 1));
                    const s16x4 hi = trrd(Ks + kcw * 16384 + imgoff(32 * ss + 8 * q + 4 + qq, 2 * cc + (p >> 1)) + 8 * (p & 1));
                    ka[ss][kt] = __builtin_shufflevector(lo, hi, 0, 1, 2, 3, 4, 5, 6, 7); }
            {
                bf16x8 cb[3];
#pragma unroll
                for (int vt = 0; vt < 3; ++vt) { v4u p; p.x = cvtpk(C[hf][0][vt][0], C[hf][0][vt][1]); p.y = cvtpk(C[hf][0][vt][2], C[hf][0][vt][3]); p.z = cvtpk(C[hf][1][vt][0], C[hf][1][vt][1]); p.w = cvtpk(C[hf][1][vt][2], C[hf][1][vt][3]); cb[vt] = __builtin_bit_cast(bf16x8, p); }
#pragma unroll
                for (int t4 = 0; t4 < 4; ++t4)
#pragma unroll
                    for (int vt = 0; vt < 3; ++vt) G[t4][vt] = ML_MFMA(qa[t4], cb[vt], G[t4][vt]);
            }
            if (hf == 0) { TP_END(2); TP_BEGIN(8); __syncthreads(); TP_END(8);
                if (c + 1 < nchunk) ML_DMA_VT(c + 1); TP_BEGIN(2); }
#pragma unroll
            for (int kt = 0; kt < 2; ++kt)
#pragma unroll
                for (int vt = 0; vt < 3; ++vt) C[hf][kt][vt] = C[hf][kt][vt] * decay;
#pragma unroll
            for (int ss = 0; ss < 2; ++ss) {
                bf16x8 bw[3];
#pragma unroll
                for (int vt = 0; vt < 3; ++vt) { const int row = vt < 2 ? 16 * vt + l15 : (l15 == 0 ? 32 : 33); bw[vt] = *(const LAS bf16x8*)(L + L_VWT + row * 128 + 16 * ((4 * ss + q) ^ (row & 7))); }
#pragma unroll
                for (int kt = 0; kt < 2; ++kt)
#pragma unroll
                    for (int vt = 0; vt < 3; ++vt) C[hf][kt][vt] = ML_MFMA(ka[ss][kt], bw[vt], C[hf][kt][vt]);
            }
            TP_END(2); TP_BEGIN(3);
            ML_VMWAIT(); __syncthreads();
            TP_END(3);
        }
        TP_BEGIN(5);
#pragma unroll
        for (int t4 = 0; t4 < 4; ++t4) { const f32x4 it = *(const LAS f32x4*)(TB + 128 + 16 * t4 + 4 * q);
#pragma unroll
            for (int vt = 0; vt < 3; ++vt) G[t4][vt] = G[t4][vt] * it; }
        {
            const int row = 16 * tt + l15; const bf16x8 a = *(const LAS bf16x8*)(L + L_SD + row * 128 + 16 * ((4 * sp + q) ^ (row & 7)));
#pragma unroll
            for (int vt = 0; vt < 3; ++vt) { const int vr = vt < 2 ? 16 * vt + l15 : (l15 == 0 ? 32 : 33); const bf16x8 bb = *(const LAS bf16x8*)(L + L_VT + vr * 128 + 16 * ((4 * sp + q) ^ (vr & 7)));
#pragma unroll
                for (int t4 = 0; t4 < 4; ++t4) if (t4 == tt) G[t4][vt] = ML_MFMA(a, bb, G[t4][vt]); }
        }
        {
            LAS float* PART = (LAS float*)(L + L_RING + SLOTB); LAS float* PDEN = (LAS float*)(L + L_PDEN);
#pragma unroll
            for (int t4 = 0; t4 < 4; ++t4)
#pragma unroll
                for (int r = 0; r < 4; ++r) { const int t = 16 * t4 + 4 * q + r; PART[(w * 64 + t) * 32 + l15] = G[t4][0][r]; PART[(w * 64 + t) * 32 + 16 + l15] = G[t4][1][r]; }
            if (l15 == 0) {
#pragma unroll
                for (int t4 = 0; t4 < 4; ++t4) *(LAS f32x4*)(PDEN + w * 64 + 16 * t4 + 4 * q) = G[t4][2]; }
        }
        __syncthreads();
        TP_END(5); TP_BEGIN(6);
        if (c + 1 < nchunk) ML_DMA_SD(c + 1);
        {
            const LAS float* PART = (const LAS float*)(L + L_RING + SLOTB); const LAS float* PDEN = (const LAS float*)(L + L_PDEN);
            const int t = tidc >> 3, cg = tidc & 7; const float em = TB[256 + t];
            f32x4 nv = *(const LAS f32x4*)(PART + t * 32 + 4 * cg); float den = PDEN[t];
#pragma unroll
            for (int ww = 1; ww < 8; ++ww) { nv += *(const LAS f32x4*)(PART + (ww * 64 + t) * 32 + 4 * cg); den += PDEN[ww * 64 + t]; }
            const float rd = 1.0f / fmaxf(fabsf(den), em);
            *(f32x4*)(Hg + (size_t)(c * 64 + t) * DM + 4 * cg) = nv * rd;
        }
        TP_END(6);
    }
    const int lane = lane0, l15 = lane & 15, q = lane >> 4;
#pragma unroll
    for (int hf = 0; hf < 2; ++hf)
#pragma unroll
        for (int kt = 0; kt < 2; ++kt)
#pragma unroll
            for (int r = 0; r < 4; ++r) { const int k = 256 * hf + 32 * w + 16 * kt + 4 * q + r;
                Cout[(size_t)k * 512 + vs * 32 + l15] = C[hf][kt][0][r]; Cout[(size_t)k * 512 + vs * 32 + 16 + l15] = C[hf][kt][1][r];
                if (vs == 0 && l15 == 0) nout[k] = C[hf][kt][2][r]; }
#ifdef TPROBE
    if (TPROBE == 99) tp_acc = 100000ull;
    if (TPROBE == 9) tp_acc = __builtin_amdgcn_s_memtime() - tp_job0;
    if (bh == 0 && vs == 0 && tid == 0) F.out[O_MP] += 1e-4f * (float)tp_acc;
#endif
    ML_VMWAIT(); __syncthreads();
#undef ML_SRCOFF
#undef ML_DMA_SLOT
#undef ML_DMA_VT
#undef ML_DMA_SD
#undef TP_BEGIN
#undef TP_END
}
}
namespace at {
typedef short bf16x8 __attribute__((ext_vector_type(8)));
typedef short s16x4 __attribute__((ext_vector_type(4)));
typedef float f32x16 __attribute__((ext_vector_type(16)));
constexpr int L_K = 0, L_V = 32768, L_O = 65536;
#define AT_MFMA(a, b, c) __builtin_amdgcn_mfma_f32_32x32x16_bf16((a), (b), (c), 0, 0, 0)
__device__ __forceinline__ void swa_unit(Frame& F, const float* sinks, int b, int qb, int kvh) {
    LAS unsigned char* L = F.lds;
    const int tid = F.tid, w = F.wave;
#ifdef APROBE
    unsigned long long ap_acc = 0, ap_t0 = __builtin_amdgcn_s_memtime();
#define AP_BEGIN(id) do { if (APROBE == (id)) { __builtin_amdgcn_sched_barrier(0); ap_t0 = __builtin_amdgcn_s_memtime(); __builtin_amdgcn_sched_barrier(0); } } while (0)
#define AP_END(id) do { if (APROBE == (id)) { __builtin_amdgcn_sched_barrier(0); ap_acc += __builtin_amdgcn_s_memtime() - ap_t0; __builtin_amdgcn_sched_barrier(0); } } while (0)
#else
#define AP_BEGIN(id)
#define AP_END(id)
#endif
    int lane = F.lane; asm volatile("" : "+v"(lane));
    const int l31 = lane & 31, h = lane >> 5;
    const bf16* KAp = WSB(WS_KA); const bf16* VAp = WSB(WS_VA);
    AP_BEGIN(1);
#pragma unroll
    for (int i = 0; i < 4; ++i) { const int c = tid + 512 * i, row = c >> 3, ch = c & 7, s_abs = qb * 128 - 128 + row;
        v4u kv = (v4u){0u, 0u, 0u, 0u}, vv = kv;
        if (s_abs >= 0) { const size_t g = ((size_t)(b * SEQ + s_abs) * 256 + kvh * 64 + ch * 8); kv = *(const v4u*)(KAp + g); vv = *(const v4u*)(VAp + g); }
        *(LAS v4u*)(L + L_K + row * 128 + 16 * (ch ^ ((row >> 1) & 7))) = kv;
        *(LAS v4u*)(L + L_V + row * 128 + 16 * (ch ^ (((row >> 1) & 1) << 2))) = vv; }
    __syncthreads();
    AP_END(1);
    const int head = kvh * 8 + w;
    const float LOG2E = 1.4426950408889634f, slope2 = exp2f(-0.25f * (float)(head + 1)) * LOG2E, sink2 = sinks[head] * LOG2E;
    for (int tti = 0; tti < 4; ++tti) {
        const size_t rq = (size_t)(b * SEQ + qb * 128 + 32 * tti + l31);
        const bf16* qp = WSB(WS_QA) + rq * DM + kvh * 512 + w * 64 + 8 * h;
        AP_BEGIN(2);
        bf16x8 qf[4];
#pragma unroll
        for (int st = 0; st < 4; ++st) qf[st] = *(const bf16x8*)(qp + 16 * st);
        f32x16 S[5];
#pragma unroll
        for (int j = 0; j < 5; ++j) {
#pragma unroll
            for (int r = 0; r < 16; ++r) S[j][r] = 0.f;
            const int rs = 32 * (tti + j) + l31;
#pragma unroll
            for (int st = 0; st < 4; ++st) { const bf16x8 a = *(const LAS bf16x8*)(L + L_K + rs * 128 + 16 * ((2 * st + h) ^ ((rs >> 1) & 7))); S[j] = AT_MFMA(a, qf[st], S[j]); }
        }
        AP_END(2); AP_BEGIN(3);
        const int L0 = l31 - 4 * h; const float base = -slope2 * (float)(128 + L0);
        float mx = sink2;
#pragma unroll
        for (int j = 0; j < 5; ++j) {
            const bool tv = qb > 0 || tti + j >= 4;
#pragma unroll
            for (int r = 0; r < 16; ++r) { const int cr = (r & 3) + 8 * (r >> 2);
                float x = fmaf(S[j][r], LOG2E, fmaf(slope2, (float)(32 * j + cr), base));
                if (j == 0) x = cr > L0 ? x : -INFINITY;
                if (j == 4) x = cr <= L0 ? x : -INFINITY;
                if (!tv) x = -INFINITY;
                S[j][r] = x; }
#pragma unroll
            for (int r = 0; r < 16; r += 2) mx = fmaxf(fmaxf(mx, S[j][r]), S[j][r + 1]);
        }
        mx = fmaxf(mx, __shfl_xor(mx, 32));
        float ls = 0.f;
#pragma unroll
        for (int j = 0; j < 5; ++j)
#pragma unroll
            for (int r = 0; r < 16; ++r) { const float p = __builtin_amdgcn_exp2f(S[j][r] - mx); S[j][r] = p; ls += p; }
        ls += __shfl_xor(ls, 32); ls += __builtin_amdgcn_exp2f(sink2 - mx);
        AP_END(3); AP_BEGIN(4);
        f32x16 O[2];
#pragma unroll
        for (int r = 0; r < 16; ++r) { O[0][r] = 0.f; O[1][r] = 0.f; }
        const int qq = (lane & 15) >> 2, p4 = lane & 3, blk = (lane >> 4) & 1;
#pragma unroll
        for (int j = 0; j < 5; ++j)
#pragma unroll
            for (int stp = 0; stp < 2; ++stp) {
                v4u pk; pk.x = ml::cvtpk(S[j][8 * stp + 0], S[j][8 * stp + 1]); pk.y = ml::cvtpk(S[j][8 * stp + 2], S[j][8 * stp + 3]); pk.z = ml::cvtpk(S[j][8 * stp + 4], S[j][8 * stp + 5]); pk.w = ml::cvtpk(S[j][8 * stp + 6], S[j][8 * stp + 7]);
                const bf16x8 pb = __builtin_bit_cast(bf16x8, pk);
                const int s0 = 32 * (tti + j) + 16 * stp + 4 * h + qq;
#pragma unroll
                for (int dt = 0; dt < 2; ++dt) { const int chk = 2 * (2 * dt + blk) + (p4 >> 1);
                    const s16x4 lo = ml::trrd(L + L_V + s0 * 128 + 16 * (chk ^ (((s0 >> 1) & 1) << 2)) + 8 * (p4 & 1));
                    const s16x4 hi = ml::trrd(L + L_V + (s0 + 8) * 128 + 16 * (chk ^ ((((s0 + 8) >> 1) & 1) << 2)) + 8 * (p4 & 1));
                    const bf16x8 a = __builtin_shufflevector(lo, hi, 0, 1, 2, 3, 4, 5, 6, 7);
                    O[dt] = AT_MFMA(a, pb, O[dt]); }
            }
        AP_END(4); AP_BEGIN(5);
        const float inv = 1.0f / ls;
        LAS unsigned char* stg = L + L_O + w * 4096;
#pragma unroll
        for (int dt = 0; dt < 2; ++dt)
#pragma unroll
            for (int rg = 0; rg < 4; ++rg) { const int d0 = 32 * dt + 8 * rg + 4 * h;
                const unsigned o0 = ml::cvtpk(O[dt][4 * rg + 0] * inv, O[dt][4 * rg + 1] * inv), o1 = ml::cvtpk(O[dt][4 * rg + 2] * inv, O[dt][4 * rg + 3] * inv);
                *(LAS unsigned long long*)(stg + l31 * 128 + 16 * ((d0 >> 3) ^ (l31 & 7)) + (d0 & 7) * 2) = (unsigned long long)o0 | ((unsigned long long)o1 << 32); }
        asm volatile("s_waitcnt lgkmcnt(0)" ::: "memory");
        AP_BEGIN(6);
        {
            v4u zz[4], ov[4]; size_t oo[4];
#pragma unroll
            for (int i = 0; i < 4; ++i) { const int row = 8 * i + (lane >> 3), ch = lane & 7;
                oo[i] = (size_t)(b * SEQ + qb * 128 + 32 * tti + row) * DM + kvh * 512 + w * 64 + ch * 8;
                zz[i] = *(const v4u*)(WSB(WS_SZA) + oo[i]); ov[i] = *(const LAS v4u*)(stg + row * 128 + 16 * (ch ^ (row & 7))); }
#pragma unroll
            for (int i = 0; i < 4; ++i) { v4u res; const v4u z = zz[i], o4 = ov[i];
                res.x = ml::cvtpk(bflo(o4.x) * bflo(z.x), bfhi(o4.x) * bfhi(z.x)); res.y = ml::cvtpk(bflo(o4.y) * bflo(z.y), bfhi(o4.y) * bfhi(z.y));
                res.z = ml::cvtpk(bflo(o4.z) * bflo(z.z), bfhi(o4.z) * bfhi(z.z)); res.w = ml::cvtpk(bflo(o4.w) * bflo(z.w), bfhi(o4.w) * bfhi(z.w));
                *(v4u*)(WSB(WS_BRA) + oo[i]) = res; }
        }
        asm volatile("s_waitcnt lgkmcnt(0)" ::: "memory");
        AP_END(6);
        AP_END(5);
    }
#ifdef APROBE
    if (APROBE == 9) ap_acc = __builtin_amdgcn_s_memtime() - ap_t0;
    if (APROBE == 99) ap_acc = 100000ull;
    if (b == 0 && qb == 1 && kvh == 0 && tid == 0) F.out[O_MP] += 1e-4f * (float)ap_acc;
#endif
    __syncthreads();
}
#undef AP_BEGIN
#undef AP_END
#undef AT_MFMA
}
__device__ __forceinline__ void mlstm_sample_job(Frame& F, const float* sC, const float* sn, const float* sm, int b, int h, int vh) {
    float* sqk = (float*)F.ldsg;
    float* red = sqk + 512 * 8;
    float* redn = red + 8 * 4 * 256;
    const int tid = F.tid, lane = F.lane, w = F.wave, bh = b * 4 + h, r0 = NTP + b * ST;
    float m = sm[bh], fd[4], ii[4], em[4];
#pragma unroll
    for (int t = 0; t < 4; ++t) { const float ig = WSF(WS_IG)[(size_t)(r0 + t) * 4 + h], lf = WSF(WS_LF)[(size_t)(r0 + t) * 4 + h];
        const float mn = fmaxf(lf + m, ig); fd[t] = expf(lf + m - mn); ii[t] = expf(ig - mn); em[t] = expf(-mn); m = mn; }
    float nreg = sn[(size_t)bh * 512 + tid], qn[4];
#pragma unroll
    for (int t = 0; t < 4; ++t) { const float qv = bf2f(WSB(WS_QM)[(size_t)(r0 + t) * DM + h * 512 + tid]), kv = bf2f(WSB(WS_KM)[(size_t)(r0 + t) * DM + h * 512 + tid]);
        sqk[tid * 8 + t] = qv; sqk[tid * 8 + 4 + t] = ii[t] * kv; nreg = fd[t] * nreg + ii[t] * kv; qn[t] = wave_sum(qv * nreg); }
    if (lane == 0) {
#pragma unroll
        for (int t = 0; t < 4; ++t) redn[w * 4 + t] = qn[t]; }
    f32x4 vv[4];
#pragma unroll
    for (int t = 0; t < 4; ++t) { const unsigned long long raw = *(const unsigned long long*)(WSB(WS_VM) + (size_t)(r0 + t) * DM + h * 512 + vh * 256 + 4 * lane);
        vv[t] = (f32x4){bflo((unsigned)raw), bfhi((unsigned)raw), bflo((unsigned)(raw >> 32)), bfhi((unsigned)(raw >> 32))}; }
    __syncthreads();
    const f32x4* cin = (const f32x4*)(sC + ((size_t)bh * 512 + w * 64) * 512 + vh * 256) + lane; f32x4* cout = (f32x4*)(F.out + O_CS + ((size_t)bh * 512 + w * 64) * 512 + vh * 256) + lane;
    f32x4 acc[4];
#pragma unroll
    for (int t = 0; t < 4; ++t) acc[t] = (f32x4){0.f, 0.f, 0.f, 0.f};
#pragma unroll 8
    for (int k = 0; k < 64; ++k) {
        f32x4 c = cin[(size_t)k * 128];
        const f32x4 qv = *(const f32x4*)(sqk + (w * 64 + k) * 8), kw = *(const f32x4*)(sqk + (w * 64 + k) * 8 + 4);
#pragma unroll
        for (int t = 0; t < 4; ++t) { c = c * fd[t] + vv[t] * kw[t]; acc[t] += c * qv[t]; }
        cout[(size_t)k * 128] = c;
    }
#pragma unroll
    for (int t = 0; t < 4; ++t) *(f32x4*)(red + (w * 4 + t) * 256 + 4 * lane) = acc[t];
    __syncthreads();
    {
        const int t = tid >> 7, v2 = (tid & 127) * 2;
        float den = 0.f, n0 = 0.f, n1 = 0.f;
#pragma unroll
        for (int ww = 0; ww < 8; ++ww) { den += redn[ww * 4 + t]; n0 += red[(ww * 4 + t) * 256 + v2]; n1 += red[(ww * 4 + t) * 256 + v2 + 1]; }
        const float emt = t == 0 ? em[0] : t == 1 ? em[1] : t == 2 ? em[2] : em[3];
        const float rd = 1.0f / fmaxf(fabsf(den), emt);
        *(float2*)(WSF(WS_HM) + (size_t)(r0 + t) * DM + h * 512 + vh * 256 + v2) = make_float2(n0 * rd, n1 * rd);
    }
    if (vh == 0) { F.out[O_NS + (size_t)bh * 512 + tid] = nreg; if (tid == 0) F.out[O_MS + bh] = m; }
    __syncthreads();
}
__device__ __forceinline__ void mlstm_scalar_job(Frame& F, int r0, int T, int h, int vs, const float* C0, const float* n0, float m0, float* Cout, float* nout, float* mout) {
    float* sq = (float*)F.ldsg; float* sk = sq + 512; float* sv = sk + 512; float* red = sv + 32; float* redn = red + 512;
    const int tid = F.tid, v = tid & 31, kq = tid >> 5;
    float c[32];
#pragma unroll
    for (int i = 0; i < 32; ++i) c[i] = C0 ? C0[(size_t)(kq * 32 + i) * 512 + vs * 32 + v] : 0.f;
    float nreg = n0 ? n0[tid] : 0.f, m = m0;
    for (int t = 0; t < T; ++t) {
        const size_t r = (size_t)(r0 + t);
        sq[tid] = bf2f(WSB(WS_QM)[r * DM + h * 512 + tid]); sk[tid] = bf2f(WSB(WS_KM)[r * DM + h * 512 + tid]);
        if (tid < 32) sv[tid] = bf2f(WSB(WS_VM)[r * DM + h * 512 + vs * 32 + tid]);
        const float ig = WSF(WS_IG)[r * 4 + h], lf = WSF(WS_LF)[r * 4 + h];
        __syncthreads();
        const float mn = fmaxf(lf + m, ig), fd = expf(lf + m - mn), ii = expf(ig - mn);
        const float vv = sv[v] * ii; float part = 0.f;
#pragma unroll
        for (int i = 0; i < 32; ++i) { c[i] = fd * c[i] + sk[kq * 32 + i] * vv; part += sq[kq * 32 + i] * c[i]; }
        nreg = fd * nreg + ii * sk[tid];
        const float qn = wave_sum(sq[tid] * nreg);
        if (F.lane == 0) redn[F.wave] = qn;
        red[kq * 32 + v] = part;
        __syncthreads();
        if (tid < 32) {
            float num = 0.f, den = 0.f;
#pragma unroll
            for (int q = 0; q < 16; ++q) num += red[q * 32 + tid];
#pragma unroll
            for (int w = 0; w < 8; ++w) den += redn[w];
            WSF(WS_HM)[r * DM + h * 512 + vs * 32 + tid] = num / fmaxf(fabsf(den), expf(-mn));
        }
        m = mn;
    }
#pragma unroll
    for (int i = 0; i < 32; ++i) Cout[(size_t)(kq * 32 + i) * 512 + vs * 32 + v] = c[i];
    if (vs == 0) { nout[tid] = nreg; if (tid == 0) *mout = m; }
    __syncthreads();
}
__device__ __forceinline__ float swa_row(const unsigned* Ks, const bf16* Vs, int loc, int minvalid, float qv, float slope, float sink, int lane) {
    float a0 = 0.f, a1 = 0.f;
    const unsigned* k0 = Ks + (loc + lane) * 33; const unsigned* k1 = Ks + (loc + 64 + lane) * 33;
#pragma unroll 4
    for (int dd = 0; dd < 32; ++dd) {
        const float q0 = __int_as_float(__builtin_amdgcn_readlane(__float_as_int(qv), 2 * dd)), q1 = __int_as_float(__builtin_amdgcn_readlane(__float_as_int(qv), 2 * dd + 1));
        const unsigned w0 = k0[dd], w1 = k1[dd];
        a0 += bflo(w0) * q0 + bfhi(w0) * q1; a1 += bflo(w1) * q0 + bfhi(w1) * q1;
    }
    const float l0 = (loc + lane >= minvalid) ? a0 - slope * (float)(127 - lane) : -INFINITY;
    const float l1 = (loc + 64 + lane >= minvalid) ? a1 - slope * (float)(63 - lane) : -INFINITY;
    const float mx = fmaxf(wave_max(fmaxf(l0, l1)), sink);
    const float p0 = expf(l0 - mx), p1 = expf(l1 - mx);
    const float den = wave_sum(p0 + p1) + expf(sink - mx);
    float acc = 0.f;
    const bf16* vb = Vs + (size_t)loc * 64 + lane;
#pragma unroll 4
    for (int j = 0; j < 64; ++j) {
        const float pj0 = __int_as_float(__builtin_amdgcn_readlane(__float_as_int(p0), j)), pj1 = __int_as_float(__builtin_amdgcn_readlane(__float_as_int(p1), j));
        acc += pj0 * bf2f(vb[j * 64]) + pj1 * bf2f(vb[(64 + j) * 64]);
    }
    return acc / den;
}
__device__ __forceinline__ void swa_prompt_unit(Frame& F, const float* sinks, int b, int tt, int kvh) {
    unsigned* Ks = (unsigned*)F.ldsg; bf16* Vs = (bf16*)(F.ldsg + 192 * 33 * 4);
    const int t0 = 64 * tt, tid = F.tid;
    for (int i = tid; i < 192 * 32; i += NWAVES * 64) { const int row = i >> 5, dw = i & 31; const int s = t0 - 127 + row;
        unsigned kw = 0u, vw = 0u;
        if (s >= 0 && row < 191) { const size_t g = (size_t)(b * SEQ + s) * 128 + kvh * 32 + dw; kw = ((const unsigned*)WSB(WS_KA))[g]; vw = ((const unsigned*)WSB(WS_VA))[g]; }
        Ks[row * 33 + dw] = kw; ((unsigned*)Vs)[row * 32 + dw] = vw; }
    __syncthreads();
    const int minvalid = 127 - t0 > 0 ? 127 - t0 : 0;
    for (int i = 0; i < 8; ++i) {
        const int loc = F.wave * 8 + i; const size_t r = (size_t)(b * SEQ + t0 + loc);
        for (int g = 0; g < 8; ++g) {
            const int head = kvh * 8 + g; const size_t o = r * DM + kvh * 512 + g * 64 + F.lane;
            const float res = swa_row(Ks, Vs, loc, minvalid, bf2f(WSB(WS_QA)[o]), exp2f(-0.25f * (float)(head + 1)), sinks[head], F.lane);
            WSB(WS_BRA)[o] = (bf16)f2bf(res * bf2f(WSB(WS_SZA)[o]));
        }
    }
    __syncthreads();
}
__device__ __forceinline__ void swa_sample_unit(Frame& F, const float* sinks, const float* sk, const float* sv, int b, int kvh, int th) {
    unsigned* Ks = (unsigned*)F.ldsg; bf16* Vs = (bf16*)(F.ldsg + 192 * 33 * 4);
    const int tid = F.tid;
    for (int i = tid; i < 192 * 32; i += NWAVES * 64) { const int row = i >> 5, dw = i & 31;
        unsigned kw = 0u, vw = 0u;
        if (row < 128) { const size_t g = ((size_t)(b * 128 + row) * 4 + kvh) * 64 + 2 * dw; kw = pk2(sk[g], sk[g + 1]); vw = pk2(sv[g], sv[g + 1]); }
        else if (row < 132) { const size_t g = (size_t)(NTP + b * 4 + row - 128) * 128 + kvh * 32 + dw; kw = ((const unsigned*)WSB(WS_KA))[g]; vw = ((const unsigned*)WSB(WS_VA))[g]; }
        Ks[row * 33 + dw] = kw; ((unsigned*)Vs)[row * 32 + dw] = vw; }
    __syncthreads();
    const int t = 2 * th + (F.wave & 1); const size_t r = (size_t)(NTP + b * 4 + t);
    for (int gg = 0; gg < 2; ++gg) {
        const int g = (F.wave >> 1) * 2 + gg, head = kvh * 8 + g; const size_t o = r * DM + kvh * 512 + g * 64 + F.lane;
        const float res = swa_row(Ks, Vs, t + 1, 0, bf2f(WSB(WS_QA)[o]), exp2f(-0.25f * (float)(head + 1)), sinks[head], F.lane);
        WSB(WS_BRA)[o] = (bf16)f2bf(res * bf2f(WSB(WS_SZA)[o]));
    }
    __syncthreads();
}
__device__ __forceinline__ void p2_mixers_scalar(Frame& F, const float* sC, const float* sn, const float* sm, const float* sk, const float* sv, const float* sinks) {
    constexpr int J_MP = 256, J_MS = J_MP + SB * MH * 16, J_AP = J_MS + NB * 32 * 4, J_AS = J_AP + SB * 4 * 2;
#ifndef REP2
#define REP2 0
#endif
    for (int rp_ = 0; rp_ < ((REP2 & 1) ? 2 : 1); ++rp_)
    for (int j = F.vcu; j < J_MP; j += F.G) { const int bh = j >> 4, vs = j & 15, b = bh >> 2, h = bh & 3;
#ifdef P2_ML
        ml::mlstm_job(F, bh, vs, F.out + O_CP + (size_t)bh * 512 * 512, F.out + O_NP + (size_t)bh * 512); (void)b; (void)h;
#else
        mlstm_scalar_job(F, b * SEQ, SEQ, h, vs, nullptr, nullptr, 0.f, F.out + O_CP + (size_t)bh * 512 * 512, F.out + O_NP + (size_t)bh * 512, F.out + O_MP + bh);
#endif
    }
    asm volatile("" ::: "memory");
#ifdef P2_ML
    for (int rp_ = 0; rp_ < ((REP2 & 2) ? 2 : 1); ++rp_)
    for (int j = F.vcu; j < SB * MH * 2; j += F.G) mlstm_sample_job(F, sC, sn, sm, j >> 3, (j >> 1) & 3, j & 1);
    asm volatile("" ::: "memory");
    for (int rp_ = 0; rp_ < ((REP2 & 4) ? 2 : 1); ++rp_)
    for (int j = F.vcu; j < NB * 16 * 4; j += F.G) at::swa_unit(F, sinks, j >> 6, (j >> 2) & 15, j & 3);
#else
    for (int j = J_MP + F.vcu; j < J_MS; j += F.G) { const int q = j - J_MP, bh = q >> 4, vs = q & 15, b = bh >> 2, h = bh & 3;
        mlstm_scalar_job(F, NTP + b * ST, ST, h, vs, sC + (size_t)bh * 512 * 512, sn + (size_t)bh * 512, sm[bh], F.out + O_CS + (size_t)bh * 512 * 512, F.out + O_NS + (size_t)bh * 512, F.out + O_MS + bh); }
    asm volatile("" ::: "memory");
    for (int j = J_MS + F.vcu; j < J_AP; j += F.G) { const int q = j - J_MS; swa_prompt_unit(F, sinks, q >> 7, (q >> 2) & 31, q & 3); }
#endif
    asm volatile("" ::: "memory");
    for (int rp_ = 0; rp_ < ((REP2 & 8) ? 2 : 1); ++rp_)
    for (int j = J_AP + F.vcu; j < J_AS; j += F.G) { const int q = j - J_AP; swa_sample_unit(F, sinks, sk, sv, q >> 3, (q >> 1) & 3, q & 1); }
}
__device__ __forceinline__ void p3_brm(Frame& F, const float* nw) {
    const int gw = F.vcu * NWAVES + F.wave, NGW = F.G * NWAVES, lane = F.lane;
    for (int r = gw; r < MPAD; r += NGW) {
        if (r >= NTOK) { ((v4u*)(WSB(WS_BRM) + (size_t)r * DM))[lane] = (v4u){0u, 0u, 0u, 0u}; ((v4u*)(WSB(WS_BRM) + (size_t)r * DM))[64 + lane] = (v4u){0u, 0u, 0u, 0u};
                         ((v4u*)(WSB(WS_BRM) + (size_t)r * DM))[128 + lane] = (v4u){0u, 0u, 0u, 0u}; ((v4u*)(WSB(WS_BRM) + (size_t)r * DM))[192 + lane] = (v4u){0u, 0u, 0u, 0u}; continue; }
        f32x4 a[4], b[4], w0[4], w1[4]; v4u g[4];
#pragma unroll
        for (int hh = 0; hh < 4; ++hh) { const size_t o = (size_t)r * DM + hh * 512 + lane * 8;
            a[hh] = *(const f32x4*)(WSF(WS_HM) + o); b[hh] = *(const f32x4*)(WSF(WS_HM) + o + 4); g[hh] = *(const v4u*)(WSB(WS_GM) + o);
            w0[hh] = *(const f32x4*)(nw + hh * 512 + lane * 8); w1[hh] = *(const f32x4*)(nw + hh * 512 + lane * 8 + 4); }
#pragma unroll
        for (int hh = 0; hh < 4; ++hh) { const size_t o = (size_t)r * DM + hh * 512 + lane * 8;
            const float mean = wave_sum((a[hh][0] + a[hh][1]) + (a[hh][2] + a[hh][3]) + (b[hh][0] + b[hh][1]) + (b[hh][2] + b[hh][3])) * (1.f / 512.f);
            const f32x4 da = a[hh] - mean, db = b[hh] - mean;
            const float var = wave_sum((da[0] * da[0] + da[1] * da[1]) + (da[2] * da[2] + da[3] * da[3]) + (db[0] * db[0] + db[1] * db[1]) + (db[2] * db[2] + db[3] * db[3])) * (1.f / 512.f);
            const float rstd = 1.0f / sqrtf(var + LN_EPS);
            v4u w;
            w.x = pk2(da[0] * rstd * w0[hh][0] * bflo(g[hh].x), da[1] * rstd * w0[hh][1] * bfhi(g[hh].x)); w.y = pk2(da[2] * rstd * w0[hh][2] * bflo(g[hh].y), da[3] * rstd * w0[hh][3] * bfhi(g[hh].y));
            w.z = pk2(db[0] * rstd * w1[hh][0] * bflo(g[hh].z), db[1] * rstd * w1[hh][1] * bfhi(g[hh].z)); w.w = pk2(db[2] * rstd * w1[hh][2] * bflo(g[hh].w), db[3] * rstd * w1[hh][3] * bfhi(g[hh].w));
            *(v4u*)(WSB(WS_BRM) + o) = w;
        }
    }
}
__device__ __forceinline__ void p6_ln(Frame& F, const float* lnw, const float* lnb) {
    const int gw = F.vcu * NWAVES + F.wave, NGW = F.G * NWAVES, lane = F.lane;
    for (int r = gw; r < NTOK; r += NGW) {
        f32x4* row = (f32x4*)(F.out + (size_t)r * DM) + lane;
        f32x4 v[8]; float s = 0.f;
#pragma unroll
        for (int j = 0; j < 8; ++j) { v[j] = row[64 * j]; s += (v[j][0] + v[j][1]) + (v[j][2] + v[j][3]); }
        const float mean = wave_sum(s) * (1.f / DM); float s2 = 0.f;
#pragma unroll
        for (int j = 0; j < 8; ++j) { v[j] = v[j] - mean; s2 += (v[j][0] * v[j][0] + v[j][1] * v[j][1]) + (v[j][2] * v[j][2] + v[j][3] * v[j][3]); }
        const float rstd = 1.0f / sqrtf(wave_sum(s2) * (1.f / DM) + LN_EPS);
#pragma unroll
        for (int j = 0; j < 8; ++j) { const f32x4 w = ((const f32x4*)lnw)[lane + 64 * j], bb = ((const f32x4*)lnb)[lane + 64 * j]; row[64 * j] = v[j] * rstd * w + bb; }
    }
}
template <int MODE>
__device__ __forceinline__ void skinny_unit(Frame& F, const bf16* A, const bf16* Bt, int u, const float* xs) {
    typedef short bf16x8 __attribute__((ext_vector_type(8)));
    const int lane = F.lane, l15 = lane & 15, q = lane >> 4, w = F.wave, rb = u >> 6, cb = u & 63;
    const bf16x8* ap = (const bf16x8*)(A + (size_t)(NTP + 32 * rb + l15) * DM + 256 * w + 8 * q);
    const bf16x8* bp = (const bf16x8*)(Bt + (size_t)(32 * cb + l15) * DM + 256 * w + 8 * q);
    f32x4 acc[2][2];
#pragma unroll
    for (int i = 0; i < 2; ++i)
#pragma unroll
        for (int j = 0; j < 2; ++j) acc[i][j] = (f32x4){0.f, 0.f, 0.f, 0.f};
#pragma unroll 4
    for (int ks = 0; ks < 8; ++ks) {
        const bf16x8 a0 = ap[4 * ks], a1 = ap[4 * ks + 16 * (DM / 8)], b0 = bp[4 * ks], b1 = bp[4 * ks + 16 * (DM / 8)];
        acc[0][0] = __builtin_amdgcn_mfma_f32_16x16x32_bf16(b0, a0, acc[0][0], 0, 0, 0); acc[0][1] = __builtin_amdgcn_mfma_f32_16x16x32_bf16(b0, a1, acc[0][1], 0, 0, 0);
        acc[1][0] = __builtin_amdgcn_mfma_f32_16x16x32_bf16(b1, a0, acc[1][0], 0, 0, 0); acc[1][1] = __builtin_amdgcn_mfma_f32_16x16x32_bf16(b1, a1, acc[1][1], 0, 0, 0);
    }
    LAS f32x4* RED = (LAS f32x4*)F.lds;
#pragma unroll
    for (int nt = 0; nt < 2; ++nt)
#pragma unroll
        for (int mt = 0; mt < 2; ++mt) RED[((w * 2 + nt) * 2 + mt) * 64 + lane] = acc[nt][mt];
    __syncthreads();
    if (F.tid < 256) {
        const int m = F.tid & 31, nq = F.tid >> 5, nt = nq >> 2, mt = m >> 4, src = 16 * (nq & 3) + (m & 15);
        f32x4 s = RED[(nt * 2 + mt) * 64 + src];
#pragma unroll
        for (int ww = 1; ww < 8; ++ww) s += RED[((ww * 2 + nt) * 2 + mt) * 64 + src];
        const int row = NTP + 32 * rb + m, col = 32 * cb + 4 * nq; const size_t off = (size_t)row * DM + col;
        if (MODE == 0) { const unsigned long long g = *(const unsigned long long*)(WSB(WS_SGA) + off); const unsigned g0 = (unsigned)g, g1 = (unsigned)(g >> 32);
            *(f32x4*)(WSF(WS_P) + off) = (f32x4){s[0] * bflo(g0), s[1] * bfhi(g0), s[2] * bflo(g1), s[3] * bfhi(g1)}; }
        else if (MODE == 1) { const unsigned long long g = *(const unsigned long long*)(WSB(WS_SGM) + off); const unsigned g0 = (unsigned)g, g1 = (unsigned)(g >> 32); const f32x4 p = *(const f32x4*)(WSF(WS_P) + off);
            const unsigned o0 = pk2(s[0] * bflo(g0) + p[0], s[1] * bfhi(g0) + p[1]), o1 = pk2(s[2] * bflo(g1) + p[2], s[3] * bfhi(g1) + p[3]);
            *(unsigned long long*)(WSB(WS_Y) + off) = (unsigned long long)o0 | ((unsigned long long)o1 << 32); }
        else { const f32x4 x = *(const f32x4*)(xs + (size_t)(row - NTP) * DM + col); *(f32x4*)(F.out + off) = x * DN_ALPHA + s; }
    }
    __syncthreads();
}
constexpr int N_LAUNCHES = MK_N_LAUNCHES;
constexpr int PER_PHASE = 7;
struct Args { const float* in[17]; float* out; unsigned char* ws; int ph_lo, ph_hi; };
__global__ void __launch_bounds__(NWAVES * 64, 2) hybrid_fwd(Args args) {
    extern __shared__ __attribute__((aligned(16))) unsigned char lds[];
    Frame F;
    F.lds = (LAS unsigned char*)lds; F.ldsg = lds;
    F.MISC = (volatile LAS unsigned*)(F.lds + MISC_OFF);
    F.tid = threadIdx.x; F.lane = F.tid & 63; F.wave = __builtin_amdgcn_readfirstlane(F.tid >> 6);
    F.G = gridDim.x; { const int bx = blockIdx.x; F.vcu = (F.G % 8 == 0) ? (bx % 8) * (F.G / 8) + bx / 8 : bx; }
    unsigned char* ws = args.ws;
    F.ctl = (gu32*)(ws + WS_CTL);
    F.ws = ws; F.out = args.out;
    for (int u = F.tid; u < (LDS_BYTES - LDSCTL_OFF) / 4; u += NWAVES * 64) ((LAS unsigned*)(F.lds + LDSCTL_OFF))[u] = 0u;
    __syncthreads();
    XcdBarrier bar; bar.bar = (unsigned*)(F.ctl + CW_BAR); bar.x = 0; bar.st = nullptr;
    if (N_LAUNCHES == 1) bar = xcd_barrier_post((unsigned*)(F.ctl + CW_BAR), F.MISC + 8);
    const int lo = args.ph_lo, hi = args.ph_hi;
#ifdef PSTAMP
    unsigned long long ts_a = 0, ts_b = 0;
#define STAMP(i) do { __builtin_amdgcn_sched_barrier(0); if ((i) == PSTAMP) ts_a = __builtin_amdgcn_s_memrealtime(); if ((i) == PSEND) ts_b = __builtin_amdgcn_s_memrealtime(); __builtin_amdgcn_sched_barrier(0); } while (0)
#else
#define STAMP(i)
#endif
#ifndef PHASE_MASK
#define PHASE_MASK 0x7f
#endif
#define IN(k) (((PHASE_MASK >> (k)) & 1) && lo <= (k) && (k) < hi)
#ifndef REPEAT_MASK
#define REPEAT_MASK 0
#endif
#define REP(k) for (int rep_ = 0; rep_ < (((REPEAT_MASK >> (k)) & 1) ? 2 : 1); ++rep_)
#define SEAM(k) do { STAMP(2 * (k) + 1 + ((k) >= 2 ? 2 : 0)); if (IN(k) && IN((k) + 1)) xcd_barrier(bar); STAMP(2 * (k) + 2 + ((k) >= 2 ? 2 : 0)); } while (0)
    STAMP(0);
    if (IN(0)) { REP(0) p0_prologue(F, args.in[0], args.in[1], args.in[7], args.in[12], args.in[13], args.in[14], args.in[8], args.in[9], args.in[5], args.in[6]); SEAM(0); }
    if (IN(1)) { REP(1) {
#ifdef P1STAT
        const unsigned long long p1t0_ = __builtin_amdgcn_s_memrealtime();
#endif
#ifdef P2_ML
        if ((int)blockIdx.x >= F.G - 16) { if (F.wave == 0) ml::gate_scan(F, (int)blockIdx.x - (F.G - 16), F.lane); __syncthreads(); }
#endif
        pg8::Gemm g{WSB(WS_XB), WSB(WS_WIN), MPAD, NIN, DM}; pg8::StaticOrder S; S.init(MPAD, NIN, F.G, (int)blockIdx.x);
        pg8::EpiInProj E{F.ws, F.out};
        pg8::gemm_phase<pg8::EpiInProj, pg8::StaticOrder, true, true>(F.lds + RING_OFF, g, S, E);
#ifdef P1STAT
        { const unsigned long long t1_ = __builtin_amdgcn_s_memrealtime(); const unsigned d_ = (unsigned)(t1_ - p1t0_);
          if (F.tid == 0) { const bool ten = S.nwg > 9 * F.G + (int)blockIdx.x;
            if (ten) { __hip_atomic_fetch_max((unsigned*)(F.ctl + 2048), d_, __ATOMIC_RELAXED, __HIP_MEMORY_SCOPE_AGENT); __hip_atomic_fetch_min((unsigned*)(F.ctl + 2112), 0xffffffffu - d_, __ATOMIC_RELAXED, __HIP_MEMORY_SCOPE_AGENT);
                       __hip_atomic_fetch_max((unsigned*)(F.ctl + 2176), (d_ << 8 >> 8 << 8) | 0u, __ATOMIC_RELAXED, __HIP_MEMORY_SCOPE_AGENT); __hip_atomic_fetch_max((unsigned long long*)(F.ctl + 2240), ((unsigned long long)d_ << 16) | blockIdx.x, __ATOMIC_RELAXED, __HIP_MEMORY_SCOPE_AGENT); }
            else __hip_atomic_fetch_max((unsigned*)(F.ctl + 2304), d_, __ATOMIC_RELAXED, __HIP_MEMORY_SCOPE_AGENT); } }
#endif
        }
        SEAM(1);
    }
    if (IN(2)) {
#ifdef P2_ML
        for (int j = F.vcu; j < 512; j += F.G) ml::sd_task(F, j >> 5, j & 31);
        STAMP(5);
        xcd_barrier(bar);
        STAMP(6);
#endif
        REP(2) p2_mixers_scalar(F, args.in[2], args.in[3], args.in[4], args.in[5], args.in[6], args.in[11]); SEAM(2); }
    if (IN(3)) { REP(3) {
        p3_brm(F, args.in[10]);
        pg8::Gemm g{WSB(WS_BRA), WSB(WS_WPA), NTP, DM, DM}; pg8::StaticOrder S; S.init(NTP, DM, F.G, (int)blockIdx.x);
        pg8::EpiPA E{WSB(WS_SGA), WSF(WS_P)};
        pg8::gemm_phase<pg8::EpiPA, pg8::StaticOrder, true, true>(F.lds + RING_OFF, g, S, E);
        for (int u = F.vcu; u < 256; u += F.G) skinny_unit<0>(F, WSB(WS_BRA), WSB(WS_WPA), u, nullptr); }
        SEAM(3);
    }
    if (IN(4)) { REP(4) {
        pg8::Gemm g{WSB(WS_BRM), WSB(WS_WPM), NTP, DM, DM}; pg8::StaticOrder S; S.init(NTP, DM, F.G, (int)blockIdx.x);
        pg8::EpiY E{WSB(WS_SGM), WSF(WS_P), WSB(WS_Y)};
        pg8::gemm_phase<pg8::EpiY, pg8::StaticOrder, true, true>(F.lds + RING_OFF, g, S, E);
        for (int u = F.vcu; u < 256; u += F.G) skinny_unit<1>(F, WSB(WS_BRM), WSB(WS_WPM), u, nullptr); }
        SEAM(4);
    }
    if (IN(5)) { REP(5) {
        pg8::Gemm g{WSB(WS_Y), WSB(WS_WOUT), NTP, DM, DM}; pg8::StaticOrder S; S.init(NTP, DM, F.G, (int)blockIdx.x);
        pg8::EpiOut E{args.in[0], F.out, DN_ALPHA};
        pg8::gemm_phase<pg8::EpiOut, pg8::StaticOrder, true, true>(F.lds + RING_OFF, g, S, E);
        for (int u = F.vcu; u < 256; u += F.G) skinny_unit<2>(F, WSB(WS_Y), WSB(WS_WOUT), u, args.in[1]); }
        SEAM(5);
    }
    if (IN(6)) p6_ln(F, args.in[15], args.in[16]);
    STAMP(15);
#ifdef P1STAT
    if (blockIdx.x == 0 && F.tid == 0) { float v_ = 0.f;
        if (P1STAT == 0) v_ = 16.f * (float)(__hip_atomic_load((unsigned*)(F.ctl + 2048), __ATOMIC_RELAXED, __HIP_MEMORY_SCOPE_AGENT) / 1600u);
        if (P1STAT == 1) v_ = 0.01f * (float)(0xffffffffu - __hip_atomic_load((unsigned*)(F.ctl + 2112), __ATOMIC_RELAXED, __HIP_MEMORY_SCOPE_AGENT));
        if (P1STAT == 2) v_ = (float)(__hip_atomic_load((unsigned long long*)(F.ctl + 2240), __ATOMIC_RELAXED, __HIP_MEMORY_SCOPE_AGENT) & 0xffffull);
        if (P1STAT == 3) v_ = 16.f * (float)(__hip_atomic_load((unsigned*)(F.ctl + 2304), __ATOMIC_RELAXED, __HIP_MEMORY_SCOPE_AGENT) / 1600u);
        F.out[O_MP] += v_; }
#endif
#ifdef PSTAMP
    if (blockIdx.x == PSBLOCK && F.tid == 0) F.out[O_MP] += 8.0f * (float)((unsigned)(ts_b - ts_a) / 800u);
#endif
#undef IN
#undef REP
#undef SEAM
}

extern "C" void kernel_launch(void* const* d_in, const int* in_sizes, int n_in, void* d_out, int out_size, void* d_ws, size_t ws_size, hipStream_t stream) {
    static int grid = 0;
    if (grid == 0) {
        if (n_in != 17 || out_size != (int)O_END || ws_size < WS_END) { fprintf(stderr, "kernel_launch: unexpected problem (n_in %d, out %d, ws %zu); nothing launched\n", n_in, out_size, ws_size); grid = -1; return; }
        int dev = 0, cus = 0, per_cu = 0;
        if (hipGetDevice(&dev) != hipSuccess || hipDeviceGetAttribute(&cus, hipDeviceAttributeMultiprocessorCount, dev) != hipSuccess) { fprintf(stderr, "kernel_launch: device query failed\n"); grid = -1; return; }
        if (hipFuncSetAttribute((const void*)hybrid_fwd, hipFuncAttributeMaxDynamicSharedMemorySize, LDS_BYTES) != hipSuccess) { fprintf(stderr, "kernel_launch: hipFuncSetAttribute failed\n"); grid = -1; return; }
        if (hipOccupancyMaxActiveBlocksPerMultiprocessor(&per_cu, (const void*)hybrid_fwd, NWAVES * 64, LDS_BYTES) != hipSuccess || per_cu < 1) { fprintf(stderr, "kernel_launch: occupancy query says %d blocks per CU\n", per_cu); (void)hipGetLastError(); grid = -1; return; }
        grid = cus;
    }
    if (grid < 0) return;
    (void)hipMemsetAsync((char*)d_ws + WS_CTL, 0, CTL_ZERO_BYTES, stream);
    Args a{};
    for (int i = 0; i < 17; ++i) a.in[i] = (const float*)d_in[i];
    a.out = (float*)d_out; a.ws = (unsigned char*)d_ws;
    if (N_LAUNCHES == 1) { a.ph_lo = 0; a.ph_hi = PER_PHASE; hipLaunchKernelGGL(hybrid_fwd, dim3(grid), dim3(NWAVES * 64), LDS_BYTES, stream, a); }
    else for (int li = 0; li < PER_PHASE; ++li) { a.ph_lo = li; a.ph_hi = li + 1; hipLaunchKernelGGL(hybrid_fwd, dim3(grid), dim3(NWAVES * 64), LDS_BYTES, stream, a); }
    const hipError_t le = hipPeekAtLastError();
    if (le != hipSuccess) fprintf(stderr, "kernel_launch: launch failed: %s\n", hipGetErrorName(le));
}
```

```cpp
#include <hip/hip_runtime.h>
#include <cstdio>
#include <cstdint>
#include <cmath>
#ifndef MK_N_LAUNCHES
#define MK_N_LAUNCHES 1
#endif
#define P2_ML 1
namespace pg8 {
#define PG8_LAS __attribute__((address_space(3)))
typedef unsigned short bf16_t;
typedef short bf16x8 __attribute__((ext_vector_type(8)));
typedef float f32x4 __attribute__((ext_vector_type(4)));
typedef unsigned u32x4 __attribute__((ext_vector_type(4)));
constexpr int BM = 256, BK = 64, HALF = 128, HTB = HALF * BK * 2  , STAGE_BYTES = 8 * HTB, NXCD = 8, WGM = 8;

__host__ __device__ __forceinline__ int lds_byte(int r, int c) { const int st = (r >> 4) * 2 + (c >> 5), rr = r & 15, cc = c & 31, ob = rr * 64 + cc * 2; return st * 1024 + (ob ^ (((ob >> 9) & 1) << 5)); }
__host__ __device__ __forceinline__ void stage_rc(int b, int& R, int& C) { const int st = b / 1024, sb = b % 1024, swz = sb ^ (((sb >> 9) & 1) << 5); R = (st >> 1) * 16 + swz / 64; C = (st & 1) * 32 + (swz % 64) / 2; }
__host__ __device__ __forceinline__ int perm32(int rho) { const int n = rho >> 4, i = rho & 15; return 8 * (i >> 2) + 4 * n + (i & 3); }

struct Unit { int pm, pn; };
struct Gemm { const bf16_t* A; const bf16_t* Bt; int M, N, K; };

struct StaticOrder {
    int nM, nN, nwg, G, c;
    __host__ __device__ void init(int M, int N, int G_, int c_) { nM = M / BM; nN = N / BM; nwg = nM * nN; G = G_; c = c_; }
    __host__ __device__ bool next(int i, Unit& u) const {
        const long L = (long)i * G + c; if (L >= nwg) return false;
        int wgid = (int)L; { const int q = nwg / NXCD, r = nwg % NXCD, xcd = wgid % NXCD, off = wgid / NXCD; wgid = (xcd < r ? xcd * (q + 1) : r * (q + 1) + (xcd - r) * q) + off; }
        const int nig = WGM * nN, gid = wgid / nig, fm = gid * WGM, gsz = (nM - fm) < WGM ? (nM - fm) : WGM;
        u.pm = fm + ((wgid % nig) % gsz); u.pn = (wgid % nig) / gsz; return true;
    }
    __device__ __forceinline__ void a_ready(const Unit&) const {}
    __device__ __forceinline__ void done(const Unit&) const {}
};

__device__ __forceinline__ unsigned cvt_pk_bf16(float lo, float hi) { unsigned r; asm volatile("v_cvt_pk_bf16_f32 %0, %1, %2" : "=v"(r) : "v"(lo), "v"(hi)); return r; }
typedef float f32x2 __attribute__((ext_vector_type(2)));
__device__ __forceinline__ f32x2 gelu_pk(f32x2 v) {
    const f32x2 av = __builtin_elementwise_abs(v), d = av * 0.2316418882f + 1.0f;
    f32x2 t; t.x = __builtin_amdgcn_rcpf(d.x); t.y = __builtin_amdgcn_rcpf(d.y);
    f32x2 q = t * 0.5307027145f + (-0.7265760135f); q = q * t + 0.7107068705f; q = q * t + (-0.142248368f); q = q * t + 0.127414796f; q = q * t;
    const f32x2 s = (v * v) * (-0.72134752044f);
    f32x2 e; e.x = __builtin_amdgcn_exp2f(s.x); e.y = __builtin_amdgcn_exp2f(s.y);
    const f32x2 m = v * (q * e), r = v - m;
    f32x2 o; o.x = v.x < 0.f ? m.x : r.x; o.y = v.y < 0.f ? m.y : r.y; return o;
}

template <int ACT  > struct EpiBf16 {
    static constexpr bool PERM = true, AFTER_DRAIN = false; static_assert(ACT == 0 || ACT == 1, "EpiBf16: ACT is 0 (none) or 1 (gelu_pk)");
    bf16_t* O; int ldc; const float* bias; int split_cols; size_t split_stride; float scale0;
    __device__ __forceinline__ void operator()(const f32x4 (&acc)[2][2][4][2], const Unit& u, int wr, int wc, int fr, int fq) const {
        const int row0 = u.pm * BM + wr * 64 + fr; int colt = u.pn * BM; bf16_t* base = O;
        float sc = 1.f; if (split_cols) { const int t = colt / split_cols; base += (size_t)t * split_stride; colt -= t * split_cols; if (t == 0) sc = scale0; }
        const int col0 = colt + wc * 32 + 8 * fq, bcol0 = u.pn * BM + wc * 32 + 8 * fq;
        f32x4 bv[2][2];
#pragma unroll
        for (int bj = 0; bj < 2; ++bj)
#pragma unroll
            for (int n = 0; n < 2; ++n) bv[bj][n] = bias ? *(const f32x4*)(bias + bcol0 + bj * HALF + 4 * n) : (f32x4){0.f, 0.f, 0.f, 0.f};
#pragma unroll
        for (int ai = 0; ai < 2; ++ai)
#pragma unroll
            for (int m = 0; m < 4; ++m) { bf16_t* rowp = base + (size_t)(row0 + ai * HALF + m * 16) * ldc + col0;
#pragma unroll
                for (int bj = 0; bj < 2; ++bj) { f32x4 v0 = acc[ai][bj][m][0] + bv[bj][0], v1 = acc[ai][bj][m][1] + bv[bj][1];
                    if (ACT == 1) { f32x2 a = gelu_pk((f32x2){v0[0], v0[1]}), b = gelu_pk((f32x2){v0[2], v0[3]}), c = gelu_pk((f32x2){v1[0], v1[1]}), d = gelu_pk((f32x2){v1[2], v1[3]});
                        v0 = (f32x4){a.x, a.y, b.x, b.y}; v1 = (f32x4){c.x, c.y, d.x, d.y}; }
                    v0 = v0 * sc; v1 = v1 * sc; u32x4 w; w.x = cvt_pk_bf16(v0[0], v0[1]); w.y = cvt_pk_bf16(v0[2], v0[3]); w.z = cvt_pk_bf16(v1[0], v1[1]); w.w = cvt_pk_bf16(v1[2], v1[3]);
                    *(u32x4*)(rowp + bj * HALF) = w; } }
    }
};

struct PanelStats {
    unsigned* xbuf;
    unsigned* cnt;
    unsigned* tmo;
    int ntn; float eps;
    unsigned code;
    __device__ __forceinline__ bool run(const f32x4 (&v)[2][2][4][2], const Unit& u, int wr, int wc, int fr, int fq, PG8_LAS unsigned char* lds, int wid, int lane) const {
        typedef float f32x2v __attribute__((ext_vector_type(2)));
        PG8_LAS f32x2v* P = (PG8_LAS f32x2v*)lds;
        PG8_LAS f32x2v* S = (PG8_LAS f32x2v*)(lds + 8192);
        PG8_LAS unsigned* flag = (PG8_LAS unsigned*)(lds + 8192 + 2048);
#pragma unroll
        for (int ai = 0; ai < 2; ++ai)
#pragma unroll
            for (int m = 0; m < 4; ++m) {
                float s = 0.f;
#pragma unroll
                for (int bj = 0; bj < 2; ++bj)
#pragma unroll
                    for (int n = 0; n < 2; ++n) { const f32x4 x = v[ai][bj][m][n]; s += (x[0] + x[1]) + (x[2] + x[3]); }
                s += __shfl_xor(s, 16); s += __shfl_xor(s, 32);
                const float mw = s * (1.0f / 64.0f); float q = 0.f;
#pragma unroll
                for (int bj = 0; bj < 2; ++bj)
#pragma unroll
                    for (int n = 0; n < 2; ++n) { const f32x4 d = v[ai][bj][m][n] - mw; q += (d[0] * d[0] + d[1] * d[1]) + (d[2] * d[2] + d[3] * d[3]); }
                q += __shfl_xor(q, 16); q += __shfl_xor(q, 32);
                if (fq == 0) P[(ai * HALF + wr * 64 + m * 16 + fr) * 4 + wc] = (f32x2v){mw, q};
            }
        asm volatile("s_waitcnt lgkmcnt(0)" ::: "memory"); __builtin_amdgcn_s_barrier(); asm volatile("" ::: "memory");
#if defined(BROKEN_EXCHANGE_NO_WAIT)
#warning BROKEN CONTROL BUILD: the row-statistics exchange does not wait; results are wrong by design
        if (blockIdx.x >= 64) { const long long t0_ = clock64(); while (clock64() - t0_ < 60000) __builtin_amdgcn_s_sleep(8); }
#endif
        const int row = wid * 32 + (lane & 31);
        if (lane < 32) {
            const f32x2v a = P[row * 4 + 0], b = P[row * 4 + 1], c = P[row * 4 + 2], d = P[row * 4 + 3];
            const float mt = (a.x + b.x + c.x + d.x) * 0.25f;
            const float da = a.x - mt, db = b.x - mt, dc = c.x - mt, dd = d.x - mt;
            const float m2 = (a.y + b.y) + (c.y + d.y) + 64.0f * ((da * da + db * db) + (dc * dc + dd * dd));
            unsigned long long* slot = (unsigned long long*)xbuf + ((size_t)(u.pm * BM + row) * 4 + u.pn);
            __hip_atomic_store(slot, ((unsigned long long)__float_as_uint(m2) << 32) | __float_as_uint(mt), __ATOMIC_RELAXED, __HIP_MEMORY_SCOPE_AGENT);
        }
        asm volatile("s_waitcnt vmcnt(0)" ::: "memory");
        if (lane == 0) __hip_atomic_fetch_add(cnt + 64 * u.pm, 1u, __ATOMIC_RELAXED, __HIP_MEMORY_SCOPE_AGENT);
        if (wid == 0) {
            bool dead = false; const unsigned long long t0 = __builtin_amdgcn_s_memrealtime(); const unsigned want = 8u * (unsigned)ntn;
            for (;;) {
#if defined(BROKEN_EXCHANGE_NO_WAIT)
                break;
#endif
                if ((unsigned)__builtin_amdgcn_readfirstlane(__hip_atomic_load(cnt + 64 * u.pm, __ATOMIC_RELAXED, __HIP_MEMORY_SCOPE_AGENT)) >= want) break;
                if (__builtin_amdgcn_s_memrealtime() - t0 > 2000000ull) {
                    if (lane == 0) { unsigned expect = 0u; __hip_atomic_compare_exchange_strong(tmo + 1, &expect, code | (unsigned)(u.pm & 0xff), __ATOMIC_RELAXED, __ATOMIC_RELAXED, __HIP_MEMORY_SCOPE_AGENT);
                                     __hip_atomic_store(tmo, 1u, __ATOMIC_RELAXED, __HIP_MEMORY_SCOPE_AGENT); }
                    dead = true; break; }
                __builtin_amdgcn_s_sleep(2);
            }
            __builtin_amdgcn_fence(__ATOMIC_ACQUIRE, "agent");
            if (lane == 0) flag[0] = dead ? 1u : 0u;
        }
        asm volatile("s_waitcnt vmcnt(0) lgkmcnt(0)" ::: "memory"); __builtin_amdgcn_s_barrier(); asm volatile("" ::: "memory");
        const bool bad = flag[0] != 0u;
        if (lane < 32) {
            const unsigned long long* slot = (const unsigned long long*)xbuf + (size_t)(u.pm * BM + row) * 4; float mt[4], m2[4]; float ms = 0.f;
#pragma unroll
            for (int t = 0; t < 4; ++t) { if (t < ntn) { const unsigned long long w = __hip_atomic_load(slot + t, __ATOMIC_RELAXED, __HIP_MEMORY_SCOPE_AGENT); mt[t] = __uint_as_float((unsigned)w); m2[t] = __uint_as_float((unsigned)(w >> 32)); } else { mt[t] = 0.f; m2[t] = 0.f; } ms += mt[t]; }
            const float mean = ms / (float)ntn; float q = 0.f;
#pragma unroll
            for (int t = 0; t < 4; ++t) if (t < ntn) { const float dm = mt[t] - mean; q += m2[t] + 256.0f * dm * dm; }
            S[row] = (f32x2v){mean, 1.0f / sqrtf(q / (256.0f * (float)ntn) + eps)};
        }
        asm volatile("s_waitcnt lgkmcnt(0)" ::: "memory"); __builtin_amdgcn_s_barrier(); asm volatile("" ::: "memory");
        return bad;
    }
};
struct EpiLnRes {
    static constexpr bool PERM = false, AFTER_DRAIN = true;
    const float* base; float* out; int ldc; const float* bias; PanelStats st; unsigned poison;
    __device__ __forceinline__ void fused(f32x4 (&acc)[2][2][4][2], const Unit& u, int wr, int wc, int fr, int fq, PG8_LAS unsigned char* lds, int wid, int lane) const {
        typedef float f32x2v __attribute__((ext_vector_type(2)));
        const PG8_LAS f32x2v* S = (const PG8_LAS f32x2v*)(lds + 8192);
        const int col0 = u.pn * BM + wc * 32 + 4 * fq;
#pragma unroll
        for (int bj = 0; bj < 2; ++bj)
#pragma unroll
            for (int n = 0; n < 2; ++n) { const f32x4 bv = bias ? *(const f32x4*)(bias + col0 + bj * HALF + n * 16) : (f32x4){0.f, 0.f, 0.f, 0.f};
#pragma unroll
                for (int ai = 0; ai < 2; ++ai)
#pragma unroll
                    for (int m = 0; m < 4; ++m) acc[ai][bj][m][n] += bv; }
        f32x4 pre[4][2][2];
#pragma unroll
        for (int m = 0; m < 4; ++m) { const size_t off = (size_t)(u.pm * BM + wr * 64 + m * 16 + fr) * ldc + col0;
#pragma unroll
            for (int bj = 0; bj < 2; ++bj)
#pragma unroll
                for (int n = 0; n < 2; ++n) pre[m][bj][n] = *(const f32x4*)(base + off + bj * HALF + n * 16); }
        const bool bad = st.run(acc, u, wr, wc, fr, fq, lds, wid, lane) || poison != 0u;
        const float qnan = __builtin_nanf("");
#pragma unroll
        for (int ai = 0; ai < 2; ++ai)
#pragma unroll
            for (int m = 0; m < 4; ++m) { const int r = ai * HALF + wr * 64 + m * 16 + fr; const f32x2v sr = S[r]; const size_t off = (size_t)(u.pm * BM + r) * ldc + col0;
#pragma unroll
                for (int bj = 0; bj < 2; ++bj)
#pragma unroll
                    for (int n = 0; n < 2; ++n) { const f32x4 bs = ai == 0 ? pre[m][bj][n] : *(const f32x4*)(base + off + bj * HALF + n * 16); f32x4 o = bs + (acc[ai][bj][m][n] - sr.x) * sr.y;
                        if (bad) o = (f32x4){qnan, qnan, qnan, qnan}; *(f32x4*)(out + off + bj * HALF + n * 16) = o; }
                if (m & 1) asm volatile("" ::: "memory"); }
    }
};
struct EpiLnResLn {
    static constexpr bool PERM = false, AFTER_DRAIN = true;
    const float* base; float* out; bf16_t* xn; int ldc; const float* bias; PanelStats st1, st2; unsigned poison;
    __device__ __forceinline__ void fused(f32x4 (&acc)[2][2][4][2], const Unit& u, int wr, int wc, int fr, int fq, PG8_LAS unsigned char* lds, int wid, int lane) const {
        typedef float f32x2v __attribute__((ext_vector_type(2))); typedef unsigned u32x2v __attribute__((ext_vector_type(2)));
        const PG8_LAS f32x2v* S = (const PG8_LAS f32x2v*)(lds + 8192);
        const int col0 = u.pn * BM + wc * 32 + 4 * fq;
#pragma unroll
        for (int bj = 0; bj < 2; ++bj)
#pragma unroll
            for (int n = 0; n < 2; ++n) { const f32x4 bv = bias ? *(const f32x4*)(bias + col0 + bj * HALF + n * 16) : (f32x4){0.f, 0.f, 0.f, 0.f};
#pragma unroll
                for (int ai = 0; ai < 2; ++ai)
#pragma unroll
                    for (int m = 0; m < 4; ++m) acc[ai][bj][m][n] += bv; }
        bool bad = st1.run(acc, u, wr, wc, fr, fq, lds, wid, lane) || poison != 0u;
        const float qnan = __builtin_nanf("");
#pragma unroll
        for (int ai = 0; ai < 2; ++ai)
#pragma unroll
            for (int m = 0; m < 4; ++m) { const int r = ai * HALF + wr * 64 + m * 16 + fr; const f32x2v sr = S[r]; const size_t off = (size_t)(u.pm * BM + r) * ldc + col0;
#pragma unroll
                for (int bj = 0; bj < 2; ++bj)
#pragma unroll
                    for (int n = 0; n < 2; ++n) { const f32x4 bs = *(const f32x4*)(base + off + bj * HALF + n * 16); acc[ai][bj][m][n] = bs + (acc[ai][bj][m][n] - sr.x) * sr.y; }
                asm volatile("" : "+v"(acc[ai][0][m][0]), "+v"(acc[ai][0][m][1]), "+v"(acc[ai][1][m][0]), "+v"(acc[ai][1][m][1]));
                if (m & 1) asm volatile("" ::: "memory"); }
        const bool bad1 = bad;
        bad = st2.run(acc, u, wr, wc, fr, fq, lds, wid, lane) || bad;
#pragma unroll
        for (int ai = 0; ai < 2; ++ai)
#pragma unroll
            for (int m = 0; m < 4; ++m) { const int r = ai * HALF + wr * 64 + m * 16 + fr; const f32x2v sr = S[r]; const size_t off = (size_t)(u.pm * BM + r) * ldc + col0;
#pragma unroll
                for (int bj = 0; bj < 2; ++bj)
#pragma unroll
                    for (int n = 0; n < 2; ++n) { const f32x4 x1 = acc[ai][bj][m][n]; *(f32x4*)(out + off + bj * HALF + n * 16) = bad1 ? (f32x4){qnan, qnan, qnan, qnan} : x1;
                        const f32x4 o = (x1 - sr.x) * sr.y; u32x2v w; w.x = cvt_pk_bf16(o[0], o[1]); w.y = cvt_pk_bf16(o[2], o[3]);
                        if (bad) { w.x = 0x7fc07fc0u; w.y = 0x7fc07fc0u; } *(u32x2v*)(xn + off + bj * HALF + n * 16) = w; }
                asm volatile("" ::: "memory"); }
    }
};

template <class Epi, class Sched, bool ALIGN_EPI = false, bool SP2 = false>
__device__ __forceinline__ void gemm_phase(PG8_LAS unsigned char* lds, const Gemm g, const Sched& S, const Epi& E) {
    const int tid = threadIdx.x, wid = __builtin_amdgcn_readfirstlane(tid >> 6), lane = tid & 63, wr = wid >> 2, wc = wid & 3, fr = lane & 15, fq = lane >> 4;
    const int K = g.K, nt = K / BK;
    unsigned voffA[2], voffB[2];
#pragma unroll
    for (int i = 0; i < 2; ++i) { int R, C; stage_rc(tid * 16 + i * 8192, R, C); const int Rb = Epi::PERM ? ((R & ~31) + perm32(R & 31)) : R;
        voffA[i] = (unsigned)(R * K + C) * 2u; voffB[i] = (unsigned)(Rb * K + C) * 2u; }
    const size_t kstep = (size_t)(BK * 2);
    const size_t hstep = (size_t)HALF * K * 2;
    const size_t tstep = 2 * hstep;
    const unsigned ldsw = (unsigned)wid * 1024u;
    const int aoff = lds_byte(wr * 64 + fr, fq * 8), boff = lds_byte(wc * 32 + fr, fq * 8);
#define PG8_SA(b, h) (((b) * 2 + (h)) * HTB)
#define PG8_SB(b, h) ((4 + (b) * 2 + (h)) * HTB)
#define PG8_STAGE(bufoff, gbase, voff) do { _Pragma("unroll") for (int _i = 0; _i < 2; ++_i) \
        __builtin_amdgcn_global_load_lds((const unsigned*)((const char*)(gbase) + (voff)[_i]), (PG8_LAS unsigned*)(lds + (bufoff) + ldsw + _i * 8192), 16, 0, 0); } while (0)
#define PG8_LDA(dst, b, h) do { _Pragma("unroll") for (int m = 0; m < 4; ++m) _Pragma("unroll") for (int k = 0; k < 2; ++k) dst[m][k] = *(const PG8_LAS bf16x8*)(lds + PG8_SA(b, h) + aoff + m * 2048 + k * 1024); } while (0)
#define PG8_LDB(dst, b, h) do { _Pragma("unroll") for (int n = 0; n < 2; ++n) _Pragma("unroll") for (int k = 0; k < 2; ++k) dst[n][k] = *(const PG8_LAS bf16x8*)(lds + PG8_SB(b, h) + boff + n * 2048 + k * 1024); } while (0)
#define PG8_MMA(ai, bj, At, Bt) do { __builtin_amdgcn_s_setprio(1); _Pragma("unroll") for (int m = 0; m < 4; ++m) _Pragma("unroll") for (int n = 0; n < 2; ++n) _Pragma("unroll") for (int k = 0; k < 2; ++k) \
        acc[ai][bj][m][n] = __builtin_amdgcn_mfma_f32_16x16x32_bf16(Bt[n][k], At[m][k], acc[ai][bj][m][n], 0, 0, 0); __builtin_amdgcn_s_setprio(0); } while (0)
#define PG8_WAIT_V(n) asm volatile("s_waitcnt vmcnt(" #n ")" ::: "memory")
#define PG8_WAIT_L(n) asm volatile("s_waitcnt lgkmcnt(" #n ")" ::: "memory")
#define PG8_BAR __builtin_amdgcn_s_barrier()
#define PG8_SCHED __builtin_amdgcn_sched_barrier(0)
    Unit cur, nxt; int ui = 0;
    if (!S.next(0, cur)) return;
    f32x4 acc[2][2][4][2];
#pragma unroll
    for (int a = 0; a < 2; ++a)
#pragma unroll
        for (int b = 0; b < 2; ++b)
#pragma unroll
            for (int m = 0; m < 4; ++m)
#pragma unroll
                for (int n = 0; n < 2; ++n) acc[a][b][m][n] = (f32x4){0.f, 0.f, 0.f, 0.f};
    bf16x8 At[4][2], B0[2][2], B1[2][2];
    const char* cA = (const char*)g.A + (size_t)cur.pm * tstep; const char* cB = (const char*)g.Bt + (size_t)cur.pn * tstep;
    S.a_ready(cur);
    if constexpr (SP2) {
        PG8_STAGE(PG8_SB(0, 0), cB, voffB); PG8_STAGE(PG8_SB(0, 1), cB + hstep, voffB); PG8_STAGE(PG8_SA(0, 0), cA, voffA); PG8_STAGE(PG8_SA(0, 1), cA + hstep, voffA);
        if (wr == 1) PG8_BAR;
        PG8_WAIT_V(2); PG8_BAR;
        PG8_STAGE(PG8_SB(1, 0), cB + kstep, voffB); PG8_STAGE(PG8_SA(1, 0), cA + kstep, voffA); PG8_STAGE(PG8_SB(1, 1), cB + hstep + kstep, voffB);
        PG8_WAIT_V(6); PG8_BAR;
    } else {
        PG8_STAGE(PG8_SB(0, 0), cB, voffB); PG8_STAGE(PG8_SA(0, 0), cA, voffA); PG8_STAGE(PG8_SB(0, 1), cB + hstep, voffB); PG8_STAGE(PG8_SA(0, 1), cA + hstep, voffA);
        if (wr == 1) PG8_BAR;
        PG8_WAIT_V(4); PG8_BAR;
        PG8_STAGE(PG8_SB(1, 0), cB + kstep, voffB); PG8_STAGE(PG8_SA(1, 0), cA + kstep, voffA); PG8_STAGE(PG8_SB(1, 1), cB + hstep + kstep, voffB);
        PG8_WAIT_V(6); PG8_BAR;
    }
    for (;;) {
        const bool has_next = S.next(ui + 1, nxt);
        const char* nA = has_next ? (const char*)g.A + (size_t)nxt.pm * tstep : cA; const char* nB = has_next ? (const char*)g.Bt + (size_t)nxt.pn * tstep : cB;
        for (int t = 0; t < nt; t += 2) {
            const bool last = (t == nt - 2);
            const char* a1 = cA + (size_t)(t + 1) * kstep;
            const char* a2 = last ? nA : cA + (size_t)(t + 2) * kstep; const char* b2 = last ? nB : cB + (size_t)(t + 2) * kstep;
            const char* a3 = a2 + kstep; const char* b3 = b2 + kstep;
            if (last && has_next) S.a_ready(nxt);
            if constexpr (SP2) {
            PG8_LDB(B0, 0, 0); PG8_LDB(B1, 0, 1); PG8_SCHED; PG8_LDA(At, 0, 0); PG8_STAGE(PG8_SA(1, 1), a1 + hstep, voffA);
            PG8_WAIT_V(8); PG8_WAIT_L(0); PG8_BAR; PG8_MMA(0, 0, At, B0); PG8_MMA(0, 1, At, B1); PG8_BAR; PG8_SCHED;
            PG8_LDA(At, 0, 1); PG8_STAGE(PG8_SB(0, 0), b2, voffB); PG8_STAGE(PG8_SB(0, 1), b2 + hstep, voffB); PG8_STAGE(PG8_SA(0, 0), a2, voffA);
            PG8_WAIT_V(8); PG8_WAIT_L(0); PG8_BAR; PG8_MMA(1, 0, At, B0); PG8_MMA(1, 1, At, B1); PG8_BAR; PG8_SCHED;
            PG8_LDB(B0, 1, 0); PG8_LDB(B1, 1, 1); PG8_SCHED; PG8_LDA(At, 1, 0); PG8_STAGE(PG8_SA(0, 1), a2 + hstep, voffA);
            PG8_WAIT_V(8); PG8_WAIT_L(0); PG8_BAR; PG8_MMA(0, 0, At, B0); PG8_MMA(0, 1, At, B1); PG8_BAR; PG8_SCHED;
            PG8_LDA(At, 1, 1); PG8_STAGE(PG8_SB(1, 0), b3, voffB); PG8_STAGE(PG8_SB(1, 1), b3 + hstep, voffB); PG8_STAGE(PG8_SA(1, 0), a3, voffA);
            PG8_WAIT_V(8); PG8_WAIT_L(0); PG8_BAR; PG8_MMA(1, 0, At, B0); PG8_MMA(1, 1, At, B1); PG8_BAR; PG8_SCHED;
            } else {
            PG8_LDB(B0, 0, 0); PG8_SCHED; PG8_LDA(At, 0, 0); PG8_STAGE(PG8_SA(1, 1), a1 + hstep, voffA);
            PG8_WAIT_L(8); PG8_BAR; PG8_WAIT_L(0); PG8_MMA(0, 0, At, B0); PG8_BAR; PG8_SCHED;
            PG8_LDB(B1, 0, 1); PG8_STAGE(PG8_SB(0, 0), b2, voffB);
            PG8_BAR; PG8_WAIT_L(0); PG8_MMA(0, 1, At, B1); PG8_BAR;
            PG8_LDA(At, 0, 1); PG8_STAGE(PG8_SA(0, 0), a2, voffA);
            PG8_BAR; PG8_WAIT_L(0); PG8_MMA(1, 0, At, B0); PG8_BAR; PG8_SCHED;
            PG8_STAGE(PG8_SB(0, 1), b2 + hstep, voffB);
            PG8_WAIT_V(6); PG8_BAR; PG8_MMA(1, 1, At, B1); PG8_BAR;
            PG8_LDB(B0, 1, 0); PG8_SCHED; PG8_LDA(At, 1, 0); PG8_STAGE(PG8_SA(0, 1), a2 + hstep, voffA);
            PG8_WAIT_L(8); PG8_BAR; PG8_WAIT_L(0); PG8_MMA(0, 0, At, B0); PG8_BAR; PG8_SCHED;
            PG8_LDB(B1, 1, 1); PG8_STAGE(PG8_SB(1, 0), b3, voffB);
            PG8_BAR; PG8_WAIT_L(0); PG8_MMA(0, 1, At, B1); PG8_BAR;
            PG8_LDA(At, 1, 1); PG8_STAGE(PG8_SA(1, 0), a3, voffA);
            PG8_BAR; PG8_WAIT_L(0); PG8_MMA(1, 0, At, B0); PG8_BAR; PG8_SCHED;
            PG8_STAGE(PG8_SB(1, 1), b3 + hstep, voffB);
            PG8_WAIT_V(6); PG8_BAR; PG8_MMA(1, 1, At, B1); PG8_BAR;
            }
        }
        if constexpr (ALIGN_EPI) { if (wr == 0) PG8_BAR; }
        if constexpr (!Epi::AFTER_DRAIN) { E(acc, cur, wr, wc, fr, fq); S.done(cur); }
        if (!has_next) break;
#pragma unroll
        for (int a = 0; a < 2; ++a)
#pragma unroll
            for (int b = 0; b < 2; ++b)
#pragma unroll
                for (int m = 0; m < 4; ++m)
#pragma unroll
                    for (int n = 0; n < 2; ++n) acc[a][b][m][n] = (f32x4){0.f, 0.f, 0.f, 0.f};
        cur = nxt; cA = nA; cB = nB; ++ui;
        if constexpr (ALIGN_EPI) { if (wr == 1) PG8_BAR; }
    }
    PG8_WAIT_V(0);
    if constexpr (!ALIGN_EPI) { if (wr == 0) PG8_BAR; }
    PG8_BAR;
    if constexpr (Epi::AFTER_DRAIN) { E.fused(acc, cur, wr, wc, fr, fq, lds, wid, lane); S.done(cur); }
#undef PG8_SA
#undef PG8_SB
#undef PG8_STAGE
#undef PG8_LDA
#undef PG8_LDB
#undef PG8_MMA
#undef PG8_WAIT_V
#undef PG8_WAIT_L
#undef PG8_BAR
#undef PG8_SCHED
}
}
namespace pg8 {
constexpr size_t EO_MiB = 1u << 20;
constexpr size_t EO_QM = 133 * EO_MiB, EO_KM = 166 * EO_MiB, EO_VM = 199 * EO_MiB, EO_GM = 232 * EO_MiB, EO_QA = 265 * EO_MiB, EO_SZA = 298 * EO_MiB, EO_SGM = 331 * EO_MiB, EO_SGA = 364 * EO_MiB, EO_KA = 397 * EO_MiB, EO_VA = 402 * EO_MiB;
constexpr size_t EO_KBP = 21241872, EO_VBP = 21372944, EO_KBS = 55124112, EO_VBS = 56172688;
__device__ __forceinline__ float sigmoid_f(float x) { return __builtin_amdgcn_rcpf(1.0f + __builtin_amdgcn_exp2f(-1.4426950408889634f * x)); }
__device__ __forceinline__ float bf_lo(unsigned w) { return __uint_as_float(w << 16); }
__device__ __forceinline__ float bf_hi(unsigned w) { return __uint_as_float(w & 0xffff0000u); }
struct EpiInProj {
    static constexpr bool PERM = true, AFTER_DRAIN = false;
    unsigned char* ws; float* out;
    __device__ __forceinline__ void operator()(const f32x4 (&acc)[2][2][4][2], const Unit& u, int wr, int wc, int fr, int fq) const {
        const int pn = u.pn, row0 = u.pm * BM + wr * 64 + fr, cl = wc * 32 + 8 * fq;
        if (pn >= 24 && pn < 40) {
            bf16_t* base = (bf16_t*)(ws + EO_GM) + (pn - 24) * 128 + cl;
#pragma unroll
            for (int ai = 0; ai < 2; ++ai)
#pragma unroll
                for (int m = 0; m < 4; ++m) {
                    const f32x4 o0 = acc[ai][0][m][0], o1 = acc[ai][0][m][1], z0 = acc[ai][1][m][0], z1 = acc[ai][1][m][1];
                    float g[8];
#pragma unroll
                    for (int e = 0; e < 4; ++e) { g[e] = sigmoid_f(o0[e]) * z0[e] * sigmoid_f(z0[e]); g[4 + e] = sigmoid_f(o1[e]) * z1[e] * sigmoid_f(z1[e]); }
                    u32x4 w; w.x = cvt_pk_bf16(g[0], g[1]); w.y = cvt_pk_bf16(g[2], g[3]); w.z = cvt_pk_bf16(g[4], g[5]); w.w = cvt_pk_bf16(g[6], g[7]);
                    *(u32x4*)(base + (size_t)(row0 + ai * HALF + m * 16) * 2048) = w;
                }
            return;
        }
        size_t doff; int ld = 2048, colt, mode = 0; float sc = 1.f;
        if (pn < 8) { doff = EO_QM; colt = pn * 256; sc = 0.04419417382415922f; }
        else if (pn < 16) { doff = EO_KM; colt = (pn - 8) * 256; }
        else if (pn < 24) { doff = EO_VM; colt = (pn - 16) * 256; }
        else if (pn < 48) { doff = EO_QA; colt = (pn - 40) * 256; sc = 0.125f; }
        else if (pn == 48) { doff = EO_KA; colt = 0; ld = 256; }
        else if (pn == 49) { doff = EO_VA; colt = 0; ld = 256; }
        else if (pn < 58) { doff = EO_SZA; colt = (pn - 50) * 256; mode = 1; }
        else if (pn < 66) { doff = EO_SGM; colt = (pn - 58) * 256; mode = 2; }
        else { doff = EO_SGA; colt = (pn - 66) * 256; mode = 2; }
#pragma unroll
        for (int ai = 0; ai < 2; ++ai)
#pragma unroll
            for (int m = 0; m < 4; ++m) {
                const int row = row0 + ai * HALF + m * 16;
#pragma unroll
                for (int bj = 0; bj < 2; ++bj) {
                    f32x4 v0 = acc[ai][bj][m][0] * sc, v1 = acc[ai][bj][m][1] * sc;
                    if (mode == 1) {
#pragma unroll
                        for (int e = 0; e < 4; ++e) { v0[e] = v0[e] * sigmoid_f(v0[e]); v1[e] = v1[e] * sigmoid_f(v1[e]); }
                    } else if (mode == 2) {
#pragma unroll
                        for (int e = 0; e < 4; ++e) { v0[e] = sigmoid_f(v0[e]); v1[e] = sigmoid_f(v1[e]); }
                    }
                    u32x4 w; w.x = cvt_pk_bf16(v0[0], v0[1]); w.y = cvt_pk_bf16(v0[2], v0[3]); w.z = cvt_pk_bf16(v1[0], v1[1]); w.w = cvt_pk_bf16(v1[2], v1[3]);
                    const int col = colt + bj * HALF + cl;
                    *(u32x4*)((bf16_t*)(ws + doff) + (size_t)row * ld + col) = w;
                    if (pn == 48 || pn == 49) {
                        float* o = nullptr;
                        if (row < 8192) { const int t = row & 2047; if (t >= 1920) o = (out + (pn == 48 ? EO_KBP : EO_VBP)) + ((size_t)((row >> 11) * 128 + (t - 1920)) * 256 + col); }
                        else if (row < 8320) { const int sr = row - 8192; o = (out + (pn == 48 ? EO_KBS : EO_VBS)) + ((size_t)((sr >> 2) * 128 + 124 + (sr & 3)) * 256 + col); }
                        if (o) { *(f32x4*)o = v0; *(f32x4*)(o + 4) = v1; }
                    }
                }
            }
    }
};
struct EpiPA {
    static constexpr bool PERM = true, AFTER_DRAIN = false;
    const bf16_t* SG; float* P;
    __device__ __forceinline__ void operator()(const f32x4 (&acc)[2][2][4][2], const Unit& u, int wr, int wc, int fr, int fq) const {
        const int row0 = u.pm * BM + wr * 64 + fr, col0 = u.pn * BM + wc * 32 + 8 * fq;
        u32x4 gn = *(const u32x4*)(SG + (size_t)row0 * 2048 + col0);
#pragma unroll
        for (int it = 0; it < 16; ++it) { const int ai = it >> 3, m = (it >> 1) & 3, bj = it & 1;
            const size_t off = (size_t)(row0 + ai * HALF + m * 16) * 2048 + col0 + bj * HALF;
            const u32x4 g = gn;
            if (it + 1 < 16) { const int a2 = (it + 1) >> 3, m2 = ((it + 1) >> 1) & 3, b2 = (it + 1) & 1; gn = *(const u32x4*)(SG + (size_t)(row0 + a2 * HALF + m2 * 16) * 2048 + col0 + b2 * HALF); }
            f32x4 v0 = acc[ai][bj][m][0], v1 = acc[ai][bj][m][1];
            v0[0] *= bf_lo(g.x); v0[1] *= bf_hi(g.x); v0[2] *= bf_lo(g.y); v0[3] *= bf_hi(g.y);
            v1[0] *= bf_lo(g.z); v1[1] *= bf_hi(g.z); v1[2] *= bf_lo(g.w); v1[3] *= bf_hi(g.w);
            *(f32x4*)(P + off) = v0; *(f32x4*)(P + off + 4) = v1; }
    }
};
struct EpiY {
    static constexpr bool PERM = true, AFTER_DRAIN = false;
    const bf16_t* SG; const float* P; bf16_t* Y;
    __device__ __forceinline__ void operator()(const f32x4 (&acc)[2][2][4][2], const Unit& u, int wr, int wc, int fr, int fq) const {
        const int row0 = u.pm * BM + wr * 64 + fr, col0 = u.pn * BM + wc * 32 + 8 * fq;
        const size_t off0 = (size_t)row0 * 2048 + col0;
        u32x4 gn = *(const u32x4*)(SG + off0); f32x4 pn0 = *(const f32x4*)(P + off0), pn1 = *(const f32x4*)(P + off0 + 4);
#pragma unroll
        for (int it = 0; it < 16; ++it) { const int ai = it >> 3, m = (it >> 1) & 3, bj = it & 1;
            const size_t off = (size_t)(row0 + ai * HALF + m * 16) * 2048 + col0 + bj * HALF;
            const u32x4 g = gn; const f32x4 p0 = pn0, p1 = pn1;
            if (it + 1 < 16) { const int a2 = (it + 1) >> 3, m2 = ((it + 1) >> 1) & 3, b2 = (it + 1) & 1; const size_t o2 = (size_t)(row0 + a2 * HALF + m2 * 16) * 2048 + col0 + b2 * HALF;
                gn = *(const u32x4*)(SG + o2); pn0 = *(const f32x4*)(P + o2); pn1 = *(const f32x4*)(P + o2 + 4); }
            f32x4 v0 = acc[ai][bj][m][0], v1 = acc[ai][bj][m][1];
            v0[0] = v0[0] * bf_lo(g.x) + p0[0]; v0[1] = v0[1] * bf_hi(g.x) + p0[1]; v0[2] = v0[2] * bf_lo(g.y) + p0[2]; v0[3] = v0[3] * bf_hi(g.y) + p0[3];
            v1[0] = v1[0] * bf_lo(g.z) + p1[0]; v1[1] = v1[1] * bf_hi(g.z) + p1[1]; v1[2] = v1[2] * bf_lo(g.w) + p1[2]; v1[3] = v1[3] * bf_hi(g.w) + p1[3];
            u32x4 w; w.x = cvt_pk_bf16(v0[0], v0[1]); w.y = cvt_pk_bf16(v0[2], v0[3]); w.z = cvt_pk_bf16(v1[0], v1[1]); w.w = cvt_pk_bf16(v1[2], v1[3]);
            *(u32x4*)(Y + off) = w; }
    }
};
struct EpiOut {
    static constexpr bool PERM = true, AFTER_DRAIN = false;
    const float* xp; float* out; float alpha;
    __device__ __forceinline__ void operator()(const f32x4 (&acc)[2][2][4][2], const Unit& u, int wr, int wc, int fr, int fq) const {
        const int row0 = u.pm * BM + wr * 64 + fr, col0 = u.pn * BM + wc * 32 + 8 * fq;
        const size_t off0 = (size_t)row0 * 2048 + col0;
        f32x4 xn0 = *(const f32x4*)(xp + off0), xn1 = *(const f32x4*)(xp + off0 + 4);
#pragma unroll
        for (int it = 0; it < 16; ++it) { const int ai = it >> 3, m = (it >> 1) & 3, bj = it & 1;
            const size_t off = (size_t)(row0 + ai * HALF + m * 16) * 2048 + col0 + bj * HALF;
            const f32x4 x0 = xn0, x1 = xn1;
            if (it + 1 < 16) { const int a2 = (it + 1) >> 3, m2 = ((it + 1) >> 1) & 3, b2 = (it + 1) & 1; const size_t o2 = (size_t)(row0 + a2 * HALF + m2 * 16) * 2048 + col0 + b2 * HALF;
                xn0 = *(const f32x4*)(xp + o2); xn1 = *(const f32x4*)(xp + o2 + 4); }
            *(f32x4*)(out + off) = x0 * alpha + acc[ai][bj][m][0]; *(f32x4*)(out + off + 4) = x1 * alpha + acc[ai][bj][m][1]; }
    }
};
}
#define GAS __attribute__((address_space(1)))
#define LAS __attribute__((address_space(3)))
typedef unsigned short bf16;
typedef unsigned v4u __attribute__((ext_vector_type(4)));
typedef float f32x4 __attribute__((ext_vector_type(4)));
typedef short bf16x8 __attribute__((ext_vector_type(8)));
typedef GAS unsigned gu32;
typedef GAS unsigned long long gu64;
#define RLX_AGENT __ATOMIC_RELAXED, __HIP_MEMORY_SCOPE_AGENT
#define LDS_WAIT() asm volatile("s_waitcnt lgkmcnt(0)" ::: "memory")
#define VM_WAIT() asm volatile("s_waitcnt vmcnt(0)" ::: "memory")
__device__ __forceinline__ unsigned long long rt() { return __builtin_amdgcn_s_memrealtime(); }
__device__ __forceinline__ unsigned f2bf(float f) { unsigned u = __builtin_bit_cast(unsigned, f); return (u + 0x7fffu + ((u >> 16) & 1u)) >> 16; }
__device__ __forceinline__ unsigned pk2(float lo, float hi) { return f2bf(lo) | (f2bf(hi) << 16); }

#define XB_TMO      128
#define XB_XCNT(j)  (256  + 64 * (j))
#define XB_XSUB(j)  (1280 + 64 * (j))
#define XB_XGEN(j)  (2304 + 64 * (j))
#define XB_TOP      3328
#define XB_TOPGEN   3392
#define XCD_BAR_WORDS 3456
#define XB_SPIN_CAP (1u << 18)

__device__ __forceinline__ unsigned xb_ld(unsigned* p)              { return __hip_atomic_load(p, __ATOMIC_RELAXED, __HIP_MEMORY_SCOPE_AGENT); }
__device__ __forceinline__ unsigned xb_add(unsigned* p, unsigned v) { return __hip_atomic_fetch_add(p, v, __ATOMIC_RELAXED, __HIP_MEMORY_SCOPE_AGENT); }
__device__ __forceinline__ unsigned xb_xcc_id() { return (unsigned)__builtin_amdgcn_s_getreg((3 << 11) | 20) & 0xFu; }
#define XB_SPIN(cond, bar) do { unsigned _sp = 0; while (cond) { __builtin_amdgcn_s_sleep(1); \
    if ((++_sp & 255u) == 0u) { if (xb_ld(&(bar)[XB_TMO])) break; if (_sp > XB_SPIN_CAP) { atomicAdd(&(bar)[XB_TMO], 1u); break; } } } } while (0)

struct XcdBarrier {
    unsigned* bar; unsigned x;
    volatile LAS unsigned* st;
};

__device__ __forceinline__ XcdBarrier xcd_barrier_post(unsigned* bar, volatile LAS unsigned* st) {
    XcdBarrier b; b.bar = bar; b.x = xb_xcc_id(); b.st = st;
    if (threadIdx.x == 0) (void)xb_add(&bar[XB_XCNT(b.x)], 1u);
    return b;
}
__device__ __forceinline__ void xcd_barrier_complete(unsigned* bar, unsigned x, unsigned& nloc, unsigned& nx) {
    const unsigned G = gridDim.x * gridDim.y * gridDim.z;
    unsigned sum, cnt, mine, sp = 0u;
    for (;;) {
        sum = 0u; cnt = 0u; mine = 0u;
#pragma unroll
        for (unsigned j = 0; j < 16; ++j) { const unsigned c = xb_ld(&bar[XB_XCNT(j)]); sum += c; cnt += (c > 0u) ? 1u : 0u; mine = (j == x) ? c : mine; }
        if (sum == G) break;
        __builtin_amdgcn_s_sleep(1);
        if ((++sp & 255u) == 0u) { if (xb_ld(&bar[XB_TMO])) break; if (sp > XB_SPIN_CAP) { atomicAdd(&bar[XB_TMO], 1u); break; } }
    }
    nloc = mine > 0u ? mine : 1u; nx = cnt > 0u ? cnt : 1u;
}

__device__ __forceinline__ void xcd_barrier(const XcdBarrier& b) {
    asm volatile("s_waitcnt vmcnt(0)" ::: "memory");
    __syncthreads();
    if (threadIdx.x == 0) {
        unsigned* bar = b.bar;
        __builtin_amdgcn_s_waitcnt(0);
        unsigned nloc = b.st[0], nx = b.st[1];
        if (nloc == 0u) { xcd_barrier_complete(bar, b.x, nloc, nx); b.st[0] = nloc; b.st[1] = nx; }
        const unsigned old = xb_add(&bar[XB_XSUB(b.x)], 1u);
        const unsigned gen = old / nloc;
        if (old + 1u == (gen + 1u) * nloc) {
            __builtin_amdgcn_fence(__ATOMIC_RELEASE, "agent");
            asm volatile("s_waitcnt vmcnt(0)" ::: "memory");
            const unsigned og = xb_add(&bar[XB_TOP], 1u);
            const unsigned tg = og / nx;
            if (og + 1u == (tg + 1u) * nx) xb_add(&bar[XB_TOPGEN], 1u);
            else XB_SPIN(xb_ld(&bar[XB_TOPGEN]) == tg, bar);
            __builtin_amdgcn_fence(__ATOMIC_ACQUIRE, "agent");
            xb_add(&bar[XB_XGEN(b.x)], 1u);
            asm volatile("s_waitcnt vmcnt(0)" ::: "memory");
        } else {
            XB_SPIN(xb_ld(&bar[XB_XGEN(b.x)]) == gen, bar);
            __builtin_amdgcn_fence(__ATOMIC_ACQUIRE, "agent");
            asm volatile("s_waitcnt vmcnt(0)" ::: "memory");
        }
    }
    __syncthreads();
}
constexpr int DM = 2048, NTP = 8192, NTS = 128, NTOK = NTP + NTS, MPAD = 8448;
constexpr int LDW = 18952, NIN = 18944;
constexpr int SEQ = 2048, NB = 4, SB = 32, ST = 4, MH = 4, DH = 512;
constexpr float LN_EPS = 1e-5f, DN_ALPHA = 1.189207115002721f, QM_SCALE = 0.04419417382415922f, QA_SCALE = 0.125f;
constexpr size_t O_YP = 0, O_YS = 16777216, O_CP = 17039360, O_NP = 21233664, O_MP = 21241856, O_KBP = 21241872, O_VBP = 21372944,
                 O_CS = 21504016, O_NS = 55058448, O_MS = 55123984, O_KBS = 55124112, O_VBS = 56172688, O_END = 57221264;
constexpr size_t MiB = 1u << 20;
constexpr size_t WS_CTL = 0, CTL_ZERO_BYTES = 1 * MiB;
constexpr size_t WS_WIN = 2 * MiB, WS_P = 2 * MiB  , WS_WPM = 76 * MiB, WS_WPA = 84 * MiB, WS_WOUT = 92 * MiB;
constexpr size_t WS_XB = 100 * MiB, WS_Y = 100 * MiB  ;
constexpr size_t WS_QM = 133 * MiB, WS_KM = 166 * MiB, WS_VM = 199 * MiB, WS_GM = 232 * MiB, WS_QA = 265 * MiB, WS_SZA = 298 * MiB, WS_SGM = 331 * MiB, WS_SGA = 364 * MiB;
constexpr size_t WS_KA = 397 * MiB, WS_VA = 402 * MiB, WS_HM = 407 * MiB, WS_BRM = 473 * MiB, WS_BRA = 506 * MiB, WS_IG = 539 * MiB, WS_LF = 540 * MiB, WS_GT = 541 * MiB  , WS_SD = 543 * MiB  , WS_END = 548 * MiB;
constexpr int CW_BAR = 4096;
constexpr int NWAVES = 8;
constexpr int RING_OFF = 0, RING_BYTES = 131072, LDS_BYTES = 163840, LDSCTL_OFF = LDS_BYTES - 256, MISC_OFF = LDSCTL_OFF;
struct Frame {
    LAS unsigned char* lds; unsigned char* ldsg;
    volatile LAS unsigned* MISC; gu32* ctl;
    int tid, lane, wave, vcu, G;
    unsigned char* ws; float* out;
};
#define WSB(off) ((bf16*)(F.ws + (off)))
#define WSF(off) ((float*)(F.ws + (off)))
__device__ __forceinline__ float wave_sum(float v) {
#pragma unroll
    for (int o = 1; o < 64; o <<= 1) v += __shfl_xor(v, o);
    return v;
}
__device__ __forceinline__ float wave_max(float v) {
#pragma unroll
    for (int o = 1; o < 64; o <<= 1) v = fmaxf(v, __shfl_xor(v, o));
    return v;
}
__device__ __forceinline__ float bf2f(bf16 h) { return __uint_as_float((unsigned)h << 16); }
__device__ __forceinline__ float bflo(unsigned w) { return __uint_as_float(w << 16); }
__device__ __forceinline__ float bfhi(unsigned w) { return __uint_as_float(w & 0xffff0000u); }
__device__ __forceinline__ float log_sigmoid_f(float x) { return x >= 0.f ? -log1pf(expf(-x)) : x - log1pf(expf(x)); }

__device__ __forceinline__ void p0_transpose_tile(const float* W, int ldw, int srccol, int k0, bf16* WT, int K, int dstrow, LAS float* scr, int lane) {
    const int kr = lane >> 4, nc = lane & 15;
    f32x4 v[16];
#pragma unroll
    for (int i = 0; i < 16; ++i) v[i] = *(const f32x4*)(W + (size_t)(k0 + 4 * i + kr) * ldw + srccol + 4 * nc);
#pragma unroll
    for (int i = 0; i < 16; ++i) { LAS float* d = scr + (4 * i + kr) * 65 + 4 * nc; d[0] = v[i][0]; d[1] = v[i][1]; d[2] = v[i][2]; d[3] = v[i][3]; }
    LDS_WAIT(); asm volatile("" ::: "memory");
    const int c = lane & 7;
#pragma unroll
    for (int j = 0; j < 8; ++j) { const int n = (lane >> 3) + 8 * j; const LAS float* s = scr + (8 * c) * 65 + n;
        v4u o; o.x = pk2(s[0 * 65], s[1 * 65]); o.y = pk2(s[2 * 65], s[3 * 65]); o.z = pk2(s[4 * 65], s[5 * 65]); o.w = pk2(s[6 * 65], s[7 * 65]);
        *(GAS v4u*)(WT + (size_t)(dstrow + n) * K + k0 + 8 * c) = o; }
    LDS_WAIT(); asm volatile("" ::: "memory");
}
__device__ __forceinline__ int win_src_col(int vn) {
    if (vn < 6144 || vn >= 10240) return vn;
    const int j = (vn - 6144) >> 8, i = (vn - 6144) & 255;
    return i < 128 ? 6144 + 128 * j + i : 8192 + 128 * j + (i - 128);
}
__device__ __forceinline__ void p0_prologue(Frame& F, const float* xp, const float* xs, const float* w_in, const float* wpm, const float* wpa, const float* wout, const float* b_i, const float* b_f, const float* sk, const float* sv) {
    const int gw = F.vcu * NWAVES + F.wave, NGW = F.G * NWAVES, lane = F.lane;
    {
        LAS float* scr = (LAS float*)(F.lds + RING_OFF + F.wave * 16640);
        constexpr int I_IN = 32 * (NIN / 64), I_SQ = 32 * 32, NITEMS = I_IN + 3 * I_SQ;
        for (int it = gw; it < NITEMS; it += NGW) {
            int r = it;
            if (r < I_IN) { const int kb = r / (NIN / 64), nb = r % (NIN / 64); p0_transpose_tile(w_in, LDW, win_src_col(64 * nb), 64 * kb, WSB(WS_WIN), DM, 64 * nb, scr, lane); continue; }
            r -= I_IN;
            const int which = r / I_SQ; r %= I_SQ; const int kb = r / 32, nb = r % 32;
            const float* W = which == 0 ? wpm : (which == 1 ? wpa : wout); bf16* WT = which == 0 ? WSB(WS_WPM) : (which == 1 ? WSB(WS_WPA) : WSB(WS_WOUT));
            p0_transpose_tile(W, DM, 64 * nb, 64 * kb, WT, DM, 64 * nb, scr, lane);
        }
    }
    __syncthreads();
    {
        LAS float* W8 = (LAS float*)(F.lds + RING_OFF);
        {
            f32x4 t_[8];
#pragma unroll
            for (int ps = 0; ps < 1; ++ps) {
#pragma unroll
                for (int i = 0; i < 8; ++i) { const int idx = F.tid + 512 * i; const int k = idx >> 1, hf = idx & 1; t_[i] = *(const f32x4*)(w_in + (size_t)k * LDW + NIN + 4 * hf); }
#pragma unroll
                for (int i = 0; i < 8; ++i) { const int idx = F.tid + 512 * i; const int k = idx >> 1, hf = idx & 1; *(LAS f32x4*)(W8 + (((k >> 8) * 4 + (k & 3)) * 64 + ((k >> 2) & 63)) * 8 + 4 * hf) = t_[i]; }
            }
        }
        __syncthreads();
        for (int r = gw; r < MPAD; r += NGW) {
            f32x4 v[8];
            if (r < NTOK) { const GAS f32x4* xr = (const GAS f32x4*)(r < NTP ? xp + (size_t)r * DM : xs + (size_t)(r - NTP) * DM) + lane;
#pragma unroll
                for (int j = 0; j < 8; ++j) v[j] = xr[64 * j]; }
            else {
#pragma unroll
                for (int j = 0; j < 8; ++j) v[j] = (f32x4){0.f, 0.f, 0.f, 0.f}; }
            GAS unsigned long long* o8 = (GAS unsigned long long*)(WSB(WS_XB) + (size_t)r * DM) + lane;
#pragma unroll
            for (int j = 0; j < 8; ++j) o8[64 * j] = (unsigned long long)pk2(v[j].x, v[j].y) | ((unsigned long long)pk2(v[j].z, v[j].w) << 32);
            if (r < NTOK) {
                float a[8];
#pragma unroll
                for (int c = 0; c < 8; ++c) a[c] = 0.f;
#pragma unroll
                for (int j = 0; j < 8; ++j)
#pragma unroll
                    for (int e = 0; e < 4; ++e) { const LAS f32x4* wp = (const LAS f32x4*)(W8 + ((j * 4 + e) * 64 + lane) * 8); const f32x4 w0 = wp[0], w1 = wp[1]; const float xv = v[j][e];
                        a[0] += xv * w0[0]; a[1] += xv * w0[1]; a[2] += xv * w0[2]; a[3] += xv * w0[3]; a[4] += xv * w1[0]; a[5] += xv * w1[1]; a[6] += xv * w1[2]; a[7] += xv * w1[3]; }
#pragma unroll
                for (int c = 0; c < 8; ++c) a[c] = wave_sum(a[c]);
                if (lane < 8) {
                    const float s = lane == 0 ? a[0] : lane == 1 ? a[1] : lane == 2 ? a[2] : lane == 3 ? a[3] : lane == 4 ? a[4] : lane == 5 ? a[5] : lane == 6 ? a[6] : a[7];
                    if (lane < 4) WSF(WS_IG)[(size_t)r * 4 + lane] = s + b_i[lane];
                    else WSF(WS_LF)[(size_t)r * 4 + (lane - 4)] = log_sigmoid_f(s + b_f[lane - 4]);
                }
            }
        }
    }
    {
        const int gt = F.vcu * (NWAVES * 64) + F.tid, NGT = F.G * NWAVES * 64;
        const f32x4* sk4 = (const f32x4*)sk; const f32x4* sv4 = (const f32x4*)sv; f32x4* kb4 = (f32x4*)(F.out + O_KBS); f32x4* vb4 = (f32x4*)(F.out + O_VBS);
        for (int i = gt; i < SB * 124 * 64; i += NGT) { const int b = i / (124 * 64), rem = i % (124 * 64);
            kb4[(size_t)b * 128 * 64 + rem] = sk4[(size_t)b * 128 * 64 + 4 * 64 + rem]; vb4[(size_t)b * 128 * 64 + rem] = sv4[(size_t)b * 128 * 64 + 4 * 64 + rem]; }
        v4u* z = (v4u*)(WSB(WS_BRA) + (size_t)NTOK * DM);
        for (int i = gt; i < (MPAD - NTOK) * DM / 8; i += NGT) z[i] = (v4u){0u, 0u, 0u, 0u};
    }
}
namespace ml {
typedef short bf16x8 __attribute__((ext_vector_type(8)));
typedef short s16x4 __attribute__((ext_vector_type(4)));
typedef float f32x4 __attribute__((ext_vector_type(4)));
typedef float f32x2 __attribute__((ext_vector_type(2)));
typedef __bf16 bf16x2_t __attribute__((ext_vector_type(2)));
constexpr int SLOTB = 65536, L_RING = 0, L_VT = 131072, VROWS = 34, L_VWT = L_VT + VROWS * 128, L_SD = L_VWT + VROWS * 128, L_PDEN = L_SD + 8192,
              L_VRAW = L_PDEN + 2048, L_TB = L_VRAW + 4096, TBB = 2048, L_END = L_TB + 2 * TBB;
static_assert(L_END <= 163840 - 256, "mLSTM LDS map");
constexpr size_t GT_CHUNK = 6 * 64;
__device__ __forceinline__ unsigned cvtpk(float lo, float hi) { f32x2 v = {lo, hi}; bf16x2_t b = __builtin_convertvector(v, bf16x2_t); return __builtin_bit_cast(unsigned, b); }
__device__ __forceinline__ int xsw(int row) { return ((row & 3) << 2) | ((row >> 2) & 3); }
__device__ __forceinline__ int imgoff(int row, int ch) { return 256 * row + 16 * (ch ^ xsw(row)); }
__device__ __forceinline__ int voff(int row, int s) { return row * 128 + 16 * ((s >> 3) ^ (row & 7)) + (s & 7) * 2; }
__device__ __forceinline__ void glds16(const void* g, LAS unsigned char* l) { __builtin_amdgcn_global_load_lds((const unsigned*)g, (LAS unsigned*)l, 16, 0, 0); }
__device__ __forceinline__ s16x4 trrd(LAS unsigned char* p) { typedef short v4i16_t __attribute__((ext_vector_type(4))); return __builtin_bit_cast(s16x4, __builtin_amdgcn_ds_read_tr16_b64_v4i16((LAS v4i16_t*)p)); }
#define ML_MFMA(a, b, c) __builtin_amdgcn_mfma_f32_16x16x32_bf16((a), (b), (c), 0, 0, 0)
#define ML_VMWAIT() asm volatile("s_waitcnt vmcnt(0)" ::: "memory")

__device__ __forceinline__ void gate_scan(Frame& F, int bh, int lane) {
    const int b = bh >> 2, h = bh & 3; float m = 0.f;
    float* gt = WSF(WS_GT) + (size_t)bh * 32 * GT_CHUNK;
    for (int c = 0; c < 32; ++c) {
        const size_t r = (size_t)(b * SEQ + c * 64 + lane);
        const float ig = WSF(WS_IG)[r * 4 + h], lf = WSF(WS_LF)[r * 4 + h];
        float bcs = lf;
#pragma unroll
        for (int o = 1; o < 64; o <<= 1) { const float t_ = __shfl_up(bcs, o); if (lane >= o) bcs += t_; }
        const float av = ig - bcs; float pm = av;
#pragma unroll
        for (int o = 1; o < 64; o <<= 1) { const float t_ = __shfl_up(pm, o); if (lane >= o) pm = fmaxf(pm, t_); }
        const float mrow = bcs + fmaxf(pm, m);
        const float blast = __shfl(bcs, 63), mnew = blast + fmaxf(m, __shfl(pm, 63));
        float* g = gt + (size_t)c * GT_CHUNK;
        g[lane] = bcs - mrow; g[64 + lane] = av; g[128 + lane] = expf(bcs + m - mrow); g[192 + lane] = expf(blast + av - mnew); g[256 + lane] = expf(-mrow);
        g[320 + lane] = lane == 0 ? expf(blast + m - mnew) : 0.f;
        m = mnew;
    }
    if (lane == 0) F.out[O_MP + bh] = m;
}

__device__ __forceinline__ void sd_task(Frame& F, int bh, int c) {
    LAS unsigned char* L = F.lds;
    const int lane0 = F.lane, w = F.wave, b = bh >> 2, h = bh & 3, r0 = b * SEQ + c * 64;
    const char* Qg = (const char*)WSB(WS_QM) + ((size_t)r0 * DM + h * 512) * 2;
    const char* Kg = (const char*)WSB(WS_KM) + ((size_t)r0 * DM + h * 512) * 2;
    const unsigned srcbase = (unsigned)((32 * (w & 1) + (lane0 >> 4)) * (DM * 2) + ((w >> 1) & 1) * 256); const int cbx = (lane0 & 15) ^ ((lane0 >> 4) << 2);
    const char* QKg = (w < 4) ? Qg : Kg;
    const int dstbase = ((8 * w) >> 5) * 32768 + (((8 * w) >> 4) & 1) * 16384 + ((8 * w) & 15) * 1024;
#pragma unroll
    for (int hf = 0; hf < 2; ++hf)
#pragma unroll
        for (int i = 0; i < 8; ++i) glds16(QKg + hf * 512 + srcbase + (unsigned)(i * 4 * (DM * 2)) + (unsigned)((cbx ^ (i & 3)) << 4), L + L_RING + hf * SLOTB + dstbase + i * 1024);
    int lane = lane0; asm volatile("" : "+v"(lane));
    const int l15 = lane & 15, q = lane >> 4, tt = w >> 1, sp = w & 1;
    const float* g = WSF(WS_GT) + ((size_t)bh * 32 + c) * GT_CHUNK;
    const int s0 = 32 * sp + l15, s1 = s0 + 16; const float a0 = g[64 + s0], a1 = g[64 + s1];
    const f32x4 re = *(const f32x4*)(g + 16 * tt + 4 * q);
    ML_VMWAIT(); __syncthreads();
    f32x4 S0 = (f32x4){0.f, 0.f, 0.f, 0.f}, S1 = S0;
    if (2 * sp <= tt) {
#pragma unroll
        for (int hf = 0; hf < 2; ++hf) { LAS unsigned char* Qs = L + L_RING + hf * SLOTB; LAS unsigned char* Ks = Qs + 32768;
#pragma unroll 4
            for (int ks = 0; ks < 8; ++ks) { const int kc = ks >> 2, ch = 4 * (ks & 3) + q;
                const bf16x8 a = *(const LAS bf16x8*)(Qs + kc * 16384 + imgoff(16 * tt + l15, ch));
                const bf16x8 b0 = *(const LAS bf16x8*)(Ks + kc * 16384 + imgoff(32 * sp + l15, ch));
                S0 = ML_MFMA(a, b0, S0);
                if (2 * sp + 1 <= tt) { const bf16x8 b1 = *(const LAS bf16x8*)(Ks + kc * 16384 + imgoff(32 * sp + 16 + l15, ch)); S1 = ML_MFMA(a, b1, S1); } } }
    }
    bf16* sd = WSB(WS_SD) + ((size_t)bh * 32 + c) * 4096;
#pragma unroll
    for (int r = 0; r < 4; ++r) { const int t = 16 * tt + 4 * q + r;
        const float d0 = s0 <= t ? S0[r] * __expf(re[r] + a0) : 0.f, d1 = s1 <= t ? S1[r] * __expf(re[r] + a1) : 0.f;
        sd[t * 64 + s0] = (bf16)(cvtpk(d0, 0.f) & 0xffffu); sd[t * 64 + s1] = (bf16)(cvtpk(d1, 0.f) & 0xffffu); }
    __syncthreads();
}

__device__ __forceinline__ void mlstm_job(Frame& F, int bh, int vs, float* Cout, float* nout) {
    LAS unsigned char* L = F.lds;
#ifdef TPROBE
    const unsigned long long tp_job0 = __builtin_amdgcn_s_memtime(); unsigned long long tp_acc = 0, tp_t0 = 0;
#define TP_BEGIN(id) do { if (TPROBE == (id)) { __builtin_amdgcn_sched_barrier(0); tp_t0 = __builtin_amdgcn_s_memtime(); __builtin_amdgcn_sched_barrier(0); } } while (0)
#define TP_END(id) do { if (TPROBE == (id)) { __builtin_amdgcn_sched_barrier(0); tp_acc += __builtin_amdgcn_s_memtime() - tp_t0; __builtin_amdgcn_sched_barrier(0); } } while (0)
#else
#define TP_BEGIN(id)
#define TP_END(id)
#endif
    const int tid = F.tid, lane0 = F.lane, w = F.wave, b = bh >> 2, h = bh & 3, r0 = b * SEQ;
    const char* Qg = (const char*)WSB(WS_QM) + ((size_t)r0 * DM + h * 512) * 2;
    const char* Kg = (const char*)WSB(WS_KM) + ((size_t)r0 * DM + h * 512) * 2;
    const char* Vg = (const char*)WSB(WS_VM) + ((size_t)r0 * DM + h * 512 + vs * 32) * 2;
    const char* SDg = (const char*)(WSB(WS_SD) + (size_t)bh * 32 * 4096);
    const char* GTg = (const char*)(WSF(WS_GT) + (size_t)bh * 32 * GT_CHUNK);
    float* Hg = WSF(WS_HM) + (size_t)r0 * DM + h * 512 + vs * 32;
    const unsigned srcbase = (unsigned)((32 * (w & 1) + (lane0 >> 4)) * (DM * 2) + ((w >> 1) & 1) * 256); const int cbx = (lane0 & 15) ^ ((lane0 >> 4) << 2);
#define ML_SRCOFF(i_) (srcbase + (unsigned)((i_) * 4 * (DM * 2)) + (unsigned)((cbx ^ ((i_) & 3)) << 4))
    const char* QKg = (w < 4) ? Qg : Kg;
    const int dstbase = ((8 * w) >> 5) * 32768 + (((8 * w) >> 4) & 1) * 16384 + ((8 * w) & 15) * 1024;
#define ML_DMA_SLOT(step_) do { const int st_ = (step_); const char* g_ = QKg + (size_t)(st_ >> 1) * (64 * DM * 2) + (st_ & 1) * 512; LAS unsigned char* d_ = L + L_RING + (st_ & 1) * SLOTB + dstbase; \
        _Pragma("unroll") for (int i_ = 0; i_ < 8; ++i_) glds16(g_ + ML_SRCOFF(i_), d_ + i_ * 1024); } while (0)
#define ML_DMA_VT(c_) do { const int cc_ = (c_); if (w < 4) glds16(Vg + (size_t)(cc_ * 64 + 16 * w + (lane0 >> 2)) * (DM * 2) + (lane0 & 3) * 16, L + L_VRAW + w * 1024); \
        else if (w < 6) glds16(GTg + (size_t)cc_ * (GT_CHUNK * 4) + (w - 4) * 1024 + lane0 * 16, L + L_TB + (cc_ & 1) * TBB + (w - 4) * 1024); } while (0)
#define ML_DMA_SD(c_) glds16(SDg + (size_t)(c_) * 8192 + (8 * w + (lane0 >> 3)) * 128 + (((lane0 & 7) ^ ((lane0 >> 3) & 7)) << 4), L + L_SD + w * 1024)
    if (tid < 64) { *(LAS unsigned short*)(L + L_VT + voff(32, tid)) = 0x3F80; *(LAS unsigned short*)(L + L_VT + voff(33, tid)) = 0; *(LAS unsigned short*)(L + L_VWT + voff(33, tid)) = 0; }
    f32x4 C[2][2][3];
#pragma unroll
    for (int a = 0; a < 2; ++a)
#pragma unroll
        for (int bb = 0; bb < 2; ++bb)
#pragma unroll
            for (int cc = 0; cc < 3; ++cc) C[a][bb][cc] = (f32x4){0.f, 0.f, 0.f, 0.f};
    const int nchunk = 32;
    ML_DMA_SLOT(0); ML_DMA_VT(0); ML_DMA_SD(0);
    ML_VMWAIT(); __syncthreads();
    const int tt = w >> 1, sp = w & 1;
    const int kcw = w >> 2, chw = 4 * (w & 3);
    for (int c = 0; c < nchunk; ++c) {
        int lane = lane0; asm volatile("" : "+v"(lane));
        const int l15 = lane & 15, q = lane >> 4; const int tidc = w * 64 + lane;
        LAS float* TB = (LAS float*)(L + L_TB + (c & 1) * TBB);
        TP_BEGIN(1);
        if (w < 4) {
            const int s = 16 * w + (lane >> 2), part = lane & 3; const float ws = TB[192 + s];
            const v4u raw = *(const LAS v4u*)(L + L_VRAW + s * 64 + part * 16);
            const unsigned rw[4] = {raw.x, raw.y, raw.z, raw.w};
#pragma unroll
            for (int e = 0; e < 4; ++e) { const int v0 = 8 * part + 2 * e;
                *(LAS unsigned short*)(L + L_VT + voff(v0, s)) = (unsigned short)(rw[e] & 0xffffu); *(LAS unsigned short*)(L + L_VT + voff(v0 + 1, s)) = (unsigned short)(rw[e] >> 16);
                const unsigned pw = cvtpk(bflo(rw[e]) * ws, bfhi(rw[e]) * ws);
                *(LAS unsigned short*)(L + L_VWT + voff(v0, s)) = (unsigned short)(pw & 0xffffu); *(LAS unsigned short*)(L + L_VWT + voff(v0 + 1, s)) = (unsigned short)(pw >> 16); }
        } else if (w == 4) { *(LAS unsigned short*)(L + L_VWT + voff(32, lane)) = (unsigned short)(cvtpk(TB[192 + lane], 0.f) & 0xffffu); }
        const float decay = TB[320];
        f32x4 G[3][4];
#pragma unroll
        for (int a = 0; a < 3; ++a)
#pragma unroll
            for (int bb = 0; bb < 4; ++bb) G[a][bb] = (f32x4){0.f, 0.f, 0.f, 0.f};
        TP_END(1);
#pragma unroll
        for (int hf = 0; hf < 2; ++hf) {
            const int step = 2 * c + hf;
            TP_BEGIN(7); if (step + 1 < 2 * nchunk) ML_DMA_SLOT(step + 1); TP_END(7);
            TP_BEGIN(2);
            int lq_ = lane0; asm volatile("" : "+v"(lq_));
            const int l15 = lq_ & 15, q = lq_ >> 4;
            LAS unsigned char* Qs = L + L_RING + (step & 1) * SLOTB; LAS unsigned char* Ks = Qs + 32768;
            bf16x8 qa[4], ka[2][2];
#pragma unroll
            for (int t4 = 0; t4 < 4; ++t4) { const int row = 16 * t4 + l15;
                const s16x4 lo = *(const LAS s16x4*)(Qs + kcw * 16384 + imgoff(row, chw + (q >> 1)) + 8 * (q & 1));
                const s16x4 hi = *(const LAS s16x4*)(Qs + kcw * 16384 + imgoff(row, chw + 2 + (q >> 1)) + 8 * (q & 1));
                qa[t4] = __builtin_shufflevector(lo, hi, 0, 1, 2, 3, 4, 5, 6, 7); }
#pragma unroll
            for (int ss = 0; ss < 2; ++ss)
#pragma unroll
                for (int kt = 0; kt < 2; ++kt) { const int cc = 2 * (w & 3) + kt, qq = l15 >> 2, p = lq_ & 3;
                    const s16x4 lo = trrd(Ks + kcw * 16384 + imgoff(32 * ss + 8 * q + qq, 2 * cc + (p >> 1)) + 8 * (p & 1));
                    const s16x4 hi = trrd(Ks + kcw * 16384 + imgoff(32 * ss + 8 * q + 4 + qq, 2 * cc + (p >> 1)) + 8 * (p & 1));
                    ka[ss][kt] = __builtin_shufflevector(lo, hi, 0, 1, 2, 3, 4, 5, 6, 7); }
            {
                bf16x8 cb[3];
#pragma unroll
                for (int vt = 0; vt < 3; ++vt) { v4u p; p.x = cvtpk(C[hf][0][vt][0], C[hf][0][vt][1]); p.y = cvtpk(C[hf][0][vt][2], C[hf][0][vt][3]); p.z = cvtpk(C[hf][1][vt][0], C[hf][1][vt][1]); p.w = cvtpk(C[hf][1][vt][2], C[hf][1][vt][3]); cb[vt] = __builtin_bit_cast(bf16x8, p); }
#pragma unroll
                for (int t4 = 0; t4 < 4; ++t4)
#pragma unroll
                    for (int vt = 0; vt < 3; ++vt) G[vt][t4] = ML_MFMA(cb[vt], qa[t4], G[vt][t4]);
            }
            if (hf == 0) { TP_END(2); TP_BEGIN(8); __syncthreads(); TP_END(8);
                if (c + 1 < nchunk) ML_DMA_VT(c + 1); TP_BEGIN(2); }
#pragma unroll
            for (int kt = 0; kt < 2; ++kt)
#pragma unroll
                for (int vt = 0; vt < 3; ++vt) C[hf][kt][vt] = C[hf][kt][vt] * decay;
#pragma unroll
            for (int ss = 0; ss < 2; ++ss) {
                bf16x8 bw[3];
#pragma unroll
                for (int vt = 0; vt < 3; ++vt) { const int row = vt < 2 ? 16 * vt + l15 : (l15 == 0 ? 32 : 33); bw[vt] = *(const LAS bf16x8*)(L + L_VWT + row * 128 + 16 * ((4 * ss + q) ^ (row & 7))); }
#pragma unroll
                for (int kt = 0; kt < 2; ++kt)
#pragma unroll
                    for (int vt = 0; vt < 3; ++vt) C[hf][kt][vt] = ML_MFMA(ka[ss][kt], bw[vt], C[hf][kt][vt]);
            }
            TP_END(2); TP_BEGIN(3);
            ML_VMWAIT(); __syncthreads();
            TP_END(3);
        }
        TP_BEGIN(5);
#pragma unroll
        for (int t4 = 0; t4 < 4; ++t4) { const float it = TB[128 + 16 * t4 + l15];
#pragma unroll
            for (int vt = 0; vt < 3; ++vt) G[vt][t4] = G[vt][t4] * it; }
        {
            const int row = 16 * tt + l15; const bf16x8 sdf = *(const LAS bf16x8*)(L + L_SD + row * 128 + 16 * ((4 * sp + q) ^ (row & 7)));
#pragma unroll
            for (int vt = 0; vt < 3; ++vt) { const int vr = vt < 2 ? 16 * vt + l15 : (l15 == 0 ? 32 : 33); const bf16x8 bb = *(const LAS bf16x8*)(L + L_VT + vr * 128 + 16 * ((4 * sp + q) ^ (vr & 7)));
#pragma unroll
                for (int t4 = 0; t4 < 4; ++t4) if (t4 == tt) G[vt][t4] = ML_MFMA(bb, sdf, G[vt][t4]); }
        }
        {
            LAS unsigned char* PART = L + L_RING + SLOTB; LAS float* PDEN = (LAS float*)(L + L_PDEN);
#pragma unroll
            for (int t4 = 0; t4 < 4; ++t4) { const int t = 16 * t4 + l15;
#pragma unroll
                for (int vt = 0; vt < 2; ++vt) *(LAS f32x4*)(PART + (w * 64 + t) * 128 + (((4 * vt + q) ^ (t & 7)) << 4)) = G[vt][t4]; }
            if (q == 0) {
#pragma unroll
                for (int t4 = 0; t4 < 4; ++t4) PDEN[w * 64 + 16 * t4 + l15] = G[2][t4][0]; }
        }
        __syncthreads();
        TP_END(5); TP_BEGIN(6);
        if (c + 1 < nchunk) ML_DMA_SD(c + 1);
        {
            const LAS unsigned char* PART = L + L_RING + SLOTB; const LAS float* PDEN = (const LAS float*)(L + L_PDEN);
            const int t = tidc >> 3, cg = tidc & 7; const float em = TB[256 + t];
            f32x4 nv = *(const LAS f32x4*)(PART + t * 128 + ((cg ^ (t & 7)) << 4)); float den = PDEN[t];
#pragma unroll
            for (int ww = 1; ww < 8; ++ww) { nv += *(const LAS f32x4*)(PART + (ww * 64 + t) * 128 + ((cg ^ (t & 7)) << 4)); den += PDEN[ww * 64 + t]; }
            const float rd = 1.0f / fmaxf(fabsf(den), em);
            *(f32x4*)(Hg + (size_t)(c * 64 + t) * DM + 4 * cg) = nv * rd;
        }
        TP_END(6);
    }
    const int lane = lane0, l15 = lane & 15, q = lane >> 4;
#pragma unroll
    for (int hf = 0; hf < 2; ++hf)
#pragma unroll
        for (int kt = 0; kt < 2; ++kt)
#pragma unroll
            for (int r = 0; r < 4; ++r) { const int k = 256 * hf + 32 * w + 16 * kt + 4 * q + r;
                Cout[(size_t)k * 512 + vs * 32 + l15] = C[hf][kt][0][r]; Cout[(size_t)k * 512 + vs * 32 + 16 + l15] = C[hf][kt][1][r];
                if (vs == 0 && l15 == 0) nout[k] = C[hf][kt][2][r]; }
#ifdef TPROBE
    if (TPROBE == 99) tp_acc = 100000ull;
    if (TPROBE == 9) tp_acc = __builtin_amdgcn_s_memtime() - tp_job0;
    if (bh == 0 && vs == 0 && tid == 0) F.out[O_MP] += 1e-4f * (float)tp_acc;
#endif
    ML_VMWAIT(); __syncthreads();
#undef ML_SRCOFF
#undef ML_DMA_SLOT
#undef ML_DMA_VT
#undef ML_DMA_SD
#undef TP_BEGIN
#undef TP_END
}
}
namespace at {
typedef short bf16x8 __attribute__((ext_vector_type(8)));
typedef short s16x4 __attribute__((ext_vector_type(4)));
typedef float f32x16 __attribute__((ext_vector_type(16)));
constexpr int L_K = 0, L_V = 32768, L_O = 65536;
#define AT_MFMA(a, b, c) __builtin_amdgcn_mfma_f32_32x32x16_bf16((a), (b), (c), 0, 0, 0)
__device__ __forceinline__ void swa_unit(Frame& F, const float* sinks, int b, int qb, int kvh) {
    LAS unsigned char* L = F.lds;
    const int tid = F.tid, w = F.wave;
#ifdef APROBE
    unsigned long long ap_acc = 0, ap_t0 = __builtin_amdgcn_s_memtime();
#define AP_BEGIN(id) do { if (APROBE == (id)) { __builtin_amdgcn_sched_barrier(0); ap_t0 = __builtin_amdgcn_s_memtime(); __builtin_amdgcn_sched_barrier(0); } } while (0)
#define AP_END(id) do { if (APROBE == (id)) { __builtin_amdgcn_sched_barrier(0); ap_acc += __builtin_amdgcn_s_memtime() - ap_t0; __builtin_amdgcn_sched_barrier(0); } } while (0)
#else
#define AP_BEGIN(id)
#define AP_END(id)
#endif
    int lane = F.lane; asm volatile("" : "+v"(lane));
    const int l31 = lane & 31, h = lane >> 5;
    const bf16* KAp = WSB(WS_KA); const bf16* VAp = WSB(WS_VA);
    AP_BEGIN(1);
#pragma unroll
    for (int i = 0; i < 4; ++i) { const int c = tid + 512 * i, row = c >> 3, ch = c & 7, s_abs = qb * 128 - 128 + row;
        v4u kv = (v4u){0u, 0u, 0u, 0u}, vv = kv;
        if (s_abs >= 0) { const size_t g = ((size_t)(b * SEQ + s_abs) * 256 + kvh * 64 + ch * 8); kv = *(const v4u*)(KAp + g); vv = *(const v4u*)(VAp + g); }
        *(LAS v4u*)(L + L_K + row * 128 + 16 * (ch ^ ((row >> 1) & 7))) = kv;
        *(LAS v4u*)(L + L_V + row * 128 + 16 * (ch ^ (((row >> 1) & 1) << 2))) = vv; }
    __syncthreads();
    AP_END(1);
    const int head = kvh * 8 + w;
    const float LOG2E = 1.4426950408889634f, slope2 = exp2f(-0.25f * (float)(head + 1)) * LOG2E, sink2 = sinks[head] * LOG2E;
    for (int tti = 0; tti < 4; ++tti) {
        const size_t rq = (size_t)(b * SEQ + qb * 128 + 32 * tti + l31);
        const bf16* qp = WSB(WS_QA) + rq * DM + kvh * 512 + w * 64 + 8 * h;
        AP_BEGIN(2);
        bf16x8 qf[4];
#pragma unroll
        for (int st = 0; st < 4; ++st) qf[st] = *(const bf16x8*)(qp + 16 * st);
        f32x16 S[5];
#pragma unroll
        for (int j = 0; j < 5; ++j) {
#pragma unroll
            for (int r = 0; r < 16; ++r) S[j][r] = 0.f;
            const int rs = 32 * (tti + j) + l31;
#pragma unroll
            for (int st = 0; st < 4; ++st) { const bf16x8 a = *(const LAS bf16x8*)(L + L_K + rs * 128 + 16 * ((2 * st + h) ^ ((rs >> 1) & 7))); S[j] = AT_MFMA(a, qf[st], S[j]); }
        }
        AP_END(2); AP_BEGIN(3);
        const int L0 = l31 - 4 * h; const float base = -slope2 * (float)(128 + L0);
        float mx = sink2;
#pragma unroll
        for (int j = 0; j < 5; ++j) {
            const bool tv = qb > 0 || tti + j >= 4;
#pragma unroll
            for (int r = 0; r < 16; ++r) { const int cr = (r & 3) + 8 * (r >> 2);
                float x = fmaf(S[j][r], LOG2E, fmaf(slope2, (float)(32 * j + cr), base));
                if (j == 0) x = cr > L0 ? x : -INFINITY;
                if (j == 4) x = cr <= L0 ? x : -INFINITY;
                if (!tv) x = -INFINITY;
                S[j][r] = x; }
#pragma unroll
            for (int r = 0; r < 16; r += 2) mx = fmaxf(fmaxf(mx, S[j][r]), S[j][r + 1]);
        }
        mx = fmaxf(mx, __shfl_xor(mx, 32));
        float ls = 0.f;
#pragma unroll
        for (int j = 0; j < 5; ++j)
#pragma unroll
            for (int r = 0; r < 16; ++r) { const float p = __builtin_amdgcn_exp2f(S[j][r] - mx); S[j][r] = p; ls += p; }
        ls += __shfl_xor(ls, 32); ls += __builtin_amdgcn_exp2f(sink2 - mx);
        AP_END(3); AP_BEGIN(4);
        f32x16 O[2];
#pragma unroll
        for (int r = 0; r < 16; ++r) { O[0][r] = 0.f; O[1][r] = 0.f; }
        const int qq = (lane & 15) >> 2, p4 = lane & 3, blk = (lane >> 4) & 1;
#pragma unroll
        for (int j = 0; j < 5; ++j)
#pragma unroll
            for (int stp = 0; stp < 2; ++stp) {
                v4u pk; pk.x = ml::cvtpk(S[j][8 * stp + 0], S[j][8 * stp + 1]); pk.y = ml::cvtpk(S[j][8 * stp + 2], S[j][8 * stp + 3]); pk.z = ml::cvtpk(S[j][8 * stp + 4], S[j][8 * stp + 5]); pk.w = ml::cvtpk(S[j][8 * stp + 6], S[j][8 * stp + 7]);
                const bf16x8 pb = __builtin_bit_cast(bf16x8, pk);
                const int s0 = 32 * (tti + j) + 16 * stp + 4 * h + qq;
#pragma unroll
                for (int dt = 0; dt < 2; ++dt) { const int chk = 2 * (2 * dt + blk) + (p4 >> 1);
                    const s16x4 lo = ml::trrd(L + L_V + s0 * 128 + 16 * (chk ^ (((s0 >> 1) & 1) << 2)) + 8 * (p4 & 1));
                    const s16x4 hi = ml::trrd(L + L_V + (s0 + 8) * 128 + 16 * (chk ^ ((((s0 + 8) >> 1) & 1) << 2)) + 8 * (p4 & 1));
                    const bf16x8 a = __builtin_shufflevector(lo, hi, 0, 1, 2, 3, 4, 5, 6, 7);
                    O[dt] = AT_MFMA(a, pb, O[dt]); }
            }
        AP_END(4); AP_BEGIN(5);
        const float inv = 1.0f / ls;
        LAS unsigned char* stg = L + L_O + w * 4096;
#pragma unroll
        for (int dt = 0; dt < 2; ++dt)
#pragma unroll
            for (int rg = 0; rg < 4; ++rg) { const int d0 = 32 * dt + 8 * rg + 4 * h;
                const unsigned o0 = ml::cvtpk(O[dt][4 * rg + 0] * inv, O[dt][4 * rg + 1] * inv), o1 = ml::cvtpk(O[dt][4 * rg + 2] * inv, O[dt][4 * rg + 3] * inv);
                *(LAS unsigned long long*)(stg + l31 * 128 + 16 * ((d0 >> 3) ^ (l31 & 7)) + (d0 & 7) * 2) = (unsigned long long)o0 | ((unsigned long long)o1 << 32); }
        asm volatile("s_waitcnt lgkmcnt(0)" ::: "memory");
        AP_BEGIN(6);
        {
            v4u zz[4], ov[4]; size_t oo[4];
#pragma unroll
            for (int i = 0; i < 4; ++i) { const int row = 8 * i + (lane >> 3), ch = lane & 7;
                oo[i] = (size_t)(b * SEQ + qb * 128 + 32 * tti + row) * DM + kvh * 512 + w * 64 + ch * 8;
                zz[i] = *(const v4u*)(WSB(WS_SZA) + oo[i]); ov[i] = *(const LAS v4u*)(stg + row * 128 + 16 * (ch ^ (row & 7))); }
#pragma unroll
            for (int i = 0; i < 4; ++i) { v4u res; const v4u z = zz[i], o4 = ov[i];
                res.x = ml::cvtpk(bflo(o4.x) * bflo(z.x), bfhi(o4.x) * bfhi(z.x)); res.y = ml::cvtpk(bflo(o4.y) * bflo(z.y), bfhi(o4.y) * bfhi(z.y));
                res.z = ml::cvtpk(bflo(o4.z) * bflo(z.z), bfhi(o4.z) * bfhi(z.z)); res.w = ml::cvtpk(bflo(o4.w) * bflo(z.w), bfhi(o4.w) * bfhi(z.w));
                *(v4u*)(WSB(WS_BRA) + oo[i]) = res; }
        }
        asm volatile("s_waitcnt lgkmcnt(0)" ::: "memory");
        AP_END(6);
        AP_END(5);
    }
#ifdef APROBE
    if (APROBE == 9) ap_acc = __builtin_amdgcn_s_memtime() - ap_t0;
    if (APROBE == 99) ap_acc = 100000ull;
    if (b == 0 && qb == 1 && kvh == 0 && tid == 0) F.out[O_MP] += 1e-4f * (float)ap_acc;
#endif
    __syncthreads();
}
#undef AP_BEGIN
#undef AP_END
#undef AT_MFMA
}
__device__ __forceinline__ void mlstm_sample_job(Frame& F, const float* sC, const float* sn, const float* sm, int b, int h, int vh) {
    float* sqk = (float*)F.ldsg;
    float* red = sqk + 512 * 8;
    float* redn = red + 8 * 4 * 256;
    const int tid = F.tid, lane = F.lane, w = F.wave, bh = b * 4 + h, r0 = NTP + b * ST;
    float m = sm[bh], fd[4], ii[4], em[4];
#pragma unroll
    for (int t = 0; t < 4; ++t) { const float ig = WSF(WS_IG)[(size_t)(r0 + t) * 4 + h], lf = WSF(WS_LF)[(size_t)(r0 + t) * 4 + h];
        const float mn = fmaxf(lf + m, ig); fd[t] = expf(lf + m - mn); ii[t] = expf(ig - mn); em[t] = expf(-mn); m = mn; }
    float nreg = sn[(size_t)bh * 512 + tid], qn[4];
#pragma unroll
    for (int t = 0; t < 4; ++t) { const float qv = bf2f(WSB(WS_QM)[(size_t)(r0 + t) * DM + h * 512 + tid]), kv = bf2f(WSB(WS_KM)[(size_t)(r0 + t) * DM + h * 512 + tid]);
        sqk[tid * 8 + t] = qv; sqk[tid * 8 + 4 + t] = ii[t] * kv; nreg = fd[t] * nreg + ii[t] * kv; qn[t] = wave_sum(qv * nreg); }
    if (lane == 0) {
#pragma unroll
        for (int t = 0; t < 4; ++t) redn[w * 4 + t] = qn[t]; }
    f32x4 vv[4];
#pragma unroll
    for (int t = 0; t < 4; ++t) { const unsigned long long raw = *(const unsigned long long*)(WSB(WS_VM) + (size_t)(r0 + t) * DM + h * 512 + vh * 256 + 4 * lane);
        vv[t] = (f32x4){bflo((unsigned)raw), bfhi((unsigned)raw), bflo((unsigned)(raw >> 32)), bfhi((unsigned)(raw >> 32))}; }
    __syncthreads();
    const f32x4* cin = (const f32x4*)(sC + ((size_t)bh * 512 + w * 64) * 512 + vh * 256) + lane; f32x4* cout = (f32x4*)(F.out + O_CS + ((size_t)bh * 512 + w * 64) * 512 + vh * 256) + lane;
    f32x4 acc[4];
#pragma unroll
    for (int t = 0; t < 4; ++t) acc[t] = (f32x4){0.f, 0.f, 0.f, 0.f};
#pragma unroll 8
    for (int k = 0; k < 64; ++k) {
        f32x4 c = cin[(size_t)k * 128];
        const f32x4 qv = *(const f32x4*)(sqk + (w * 64 + k) * 8), kw = *(const f32x4*)(sqk + (w * 64 + k) * 8 + 4);
#pragma unroll
        for (int t = 0; t < 4; ++t) { c = c * fd[t] + vv[t] * kw[t]; acc[t] += c * qv[t]; }
        cout[(size_t)k * 128] = c;
    }
#pragma unroll
    for (int t = 0; t < 4; ++t) *(f32x4*)(red + (w * 4 + t) * 256 + 4 * lane) = acc[t];
    __syncthreads();
    {
        const int t = tid >> 7, v2 = (tid & 127) * 2;
        float den = 0.f, n0 = 0.f, n1 = 0.f;
#pragma unroll
        for (int ww = 0; ww < 8; ++ww) { den += redn[ww * 4 + t]; n0 += red[(ww * 4 + t) * 256 + v2]; n1 += red[(ww * 4 + t) * 256 + v2 + 1]; }
        const float emt = t == 0 ? em[0] : t == 1 ? em[1] : t == 2 ? em[2] : em[3];
        const float rd = 1.0f / fmaxf(fabsf(den), emt);
        *(float2*)(WSF(WS_HM) + (size_t)(r0 + t) * DM + h * 512 + vh * 256 + v2) = make_float2(n0 * rd, n1 * rd);
    }
    if (vh == 0) { F.out[O_NS + (size_t)bh * 512 + tid] = nreg; if (tid == 0) F.out[O_MS + bh] = m; }
    __syncthreads();
}
__device__ __forceinline__ void mlstm_scalar_job(Frame& F, int r0, int T, int h, int vs, const float* C0, const float* n0, float m0, float* Cout, float* nout, float* mout) {
    float* sq = (float*)F.ldsg; float* sk = sq + 512; float* sv = sk + 512; float* red = sv + 32; float* redn = red + 512;
    const int tid = F.tid, v = tid & 31, kq = tid >> 5;
    float c[32];
#pragma unroll
    for (int i = 0; i < 32; ++i) c[i] = C0 ? C0[(size_t)(kq * 32 + i) * 512 + vs * 32 + v] : 0.f;
    float nreg = n0 ? n0[tid] : 0.f, m = m0;
    for (int t = 0; t < T; ++t) {
        const size_t r = (size_t)(r0 + t);
        sq[tid] = bf2f(WSB(WS_QM)[r * DM + h * 512 + tid]); sk[tid] = bf2f(WSB(WS_KM)[r * DM + h * 512 + tid]);
        if (tid < 32) sv[tid] = bf2f(WSB(WS_VM)[r * DM + h * 512 + vs * 32 + tid]);
        const float ig = WSF(WS_IG)[r * 4 + h], lf = WSF(WS_LF)[r * 4 + h];
        __syncthreads();
        const float mn = fmaxf(lf + m, ig), fd = expf(lf + m - mn), ii = expf(ig - mn);
        const float vv = sv[v] * ii; float part = 0.f;
#pragma unroll
        for (int i = 0; i < 32; ++i) { c[i] = fd * c[i] + sk[kq * 32 + i] * vv; part += sq[kq * 32 + i] * c[i]; }
        nreg = fd * nreg + ii * sk[tid];
        const float qn = wave_sum(sq[tid] * nreg);
        if (F.lane == 0) redn[F.wave] = qn;
        red[kq * 32 + v] = part;
        __syncthreads();
        if (tid < 32) {
            float num = 0.f, den = 0.f;
#pragma unroll
            for (int q = 0; q < 16; ++q) num += red[q * 32 + tid];
#pragma unroll
            for (int w = 0; w < 8; ++w) den += redn[w];
            WSF(WS_HM)[r * DM + h * 512 + vs * 32 + tid] = num / fmaxf(fabsf(den), expf(-mn));
        }
        m = mn;
    }
#pragma unroll
    for (int i = 0; i < 32; ++i) Cout[(size_t)(kq * 32 + i) * 512 + vs * 32 + v] = c[i];
    if (vs == 0) { nout[tid] = nreg; if (tid == 0) *mout = m; }
    __syncthreads();
}
__device__ __forceinline__ float swa_row(const unsigned* Ks, const bf16* Vs, int loc, int minvalid, float qv, float slope, float sink, int lane) {
    float a0 = 0.f, a1 = 0.f;
    const unsigned* k0 = Ks + (loc + lane) * 33; const unsigned* k1 = Ks + (loc + 64 + lane) * 33;
#pragma unroll 4
    for (int dd = 0; dd < 32; ++dd) {
        const float q0 = __int_as_float(__builtin_amdgcn_readlane(__float_as_int(qv), 2 * dd)), q1 = __int_as_float(__builtin_amdgcn_readlane(__float_as_int(qv), 2 * dd + 1));
        const unsigned w0 = k0[dd], w1 = k1[dd];
        a0 += bflo(w0) * q0 + bfhi(w0) * q1; a1 += bflo(w1) * q0 + bfhi(w1) * q1;
    }
    const float l0 = (loc + lane >= minvalid) ? a0 - slope * (float)(127 - lane) : -INFINITY;
    const float l1 = (loc + 64 + lane >= minvalid) ? a1 - slope * (float)(63 - lane) : -INFINITY;
    const float mx = fmaxf(wave_max(fmaxf(l0, l1)), sink);
    const float p0 = expf(l0 - mx), p1 = expf(l1 - mx);
    const float den = wave_sum(p0 + p1) + expf(sink - mx);
    float acc = 0.f;
    const bf16* vb = Vs + (size_t)loc * 64 + lane;
#pragma unroll 4
    for (int j = 0; j < 64; ++j) {
        const float pj0 = __int_as_float(__builtin_amdgcn_readlane(__float_as_int(p0), j)), pj1 = __int_as_float(__builtin_amdgcn_readlane(__float_as_int(p1), j));
        acc += pj0 * bf2f(vb[j * 64]) + pj1 * bf2f(vb[(64 + j) * 64]);
    }
    return acc / den;
}
__device__ __forceinline__ void swa_prompt_unit(Frame& F, const float* sinks, int b, int tt, int kvh) {
    unsigned* Ks = (unsigned*)F.ldsg; bf16* Vs = (bf16*)(F.ldsg + 192 * 33 * 4);
    const int t0 = 64 * tt, tid = F.tid;
    for (int i = tid; i < 192 * 32; i += NWAVES * 64) { const int row = i >> 5, dw = i & 31; const int s = t0 - 127 + row;
        unsigned kw = 0u, vw = 0u;
        if (s >= 0 && row < 191) { const size_t g = (size_t)(b * SEQ + s) * 128 + kvh * 32 + dw; kw = ((const unsigned*)WSB(WS_KA))[g]; vw = ((const unsigned*)WSB(WS_VA))[g]; }
        Ks[row * 33 + dw] = kw; ((unsigned*)Vs)[row * 32 + dw] = vw; }
    __syncthreads();
    const int minvalid = 127 - t0 > 0 ? 127 - t0 : 0;
    for (int i = 0; i < 8; ++i) {
        const int loc = F.wave * 8 + i; const size_t r = (size_t)(b * SEQ + t0 + loc);
        for (int g = 0; g < 8; ++g) {
            const int head = kvh * 8 + g; const size_t o = r * DM + kvh * 512 + g * 64 + F.lane;
            const float res = swa_row(Ks, Vs, loc, minvalid, bf2f(WSB(WS_QA)[o]), exp2f(-0.25f * (float)(head + 1)), sinks[head], F.lane);
            WSB(WS_BRA)[o] = (bf16)f2bf(res * bf2f(WSB(WS_SZA)[o]));
        }
    }
    __syncthreads();
}
__device__ __forceinline__ void swa_sample_unit(Frame& F, const float* sinks, const float* sk, const float* sv, int b, int kvh, int th) {
    unsigned* Ks = (unsigned*)F.ldsg; bf16* Vs = (bf16*)(F.ldsg + 192 * 33 * 4);
    const int tid = F.tid;
    for (int i = tid; i < 192 * 32; i += NWAVES * 64) { const int row = i >> 5, dw = i & 31;
        unsigned kw = 0u, vw = 0u;
        if (row < 128) { const size_t g = ((size_t)(b * 128 + row) * 4 + kvh) * 64 + 2 * dw; kw = pk2(sk[g], sk[g + 1]); vw = pk2(sv[g], sv[g + 1]); }
        else if (row < 132) { const size_t g = (size_t)(NTP + b * 4 + row - 128) * 128 + kvh * 32 + dw; kw = ((const unsigned*)WSB(WS_KA))[g]; vw = ((const unsigned*)WSB(WS_VA))[g]; }
        Ks[row * 33 + dw] = kw; ((unsigned*)Vs)[row * 32 + dw] = vw; }
    __syncthreads();
    const int t = 2 * th + (F.wave & 1); const size_t r = (size_t)(NTP + b * 4 + t);
    for (int gg = 0; gg < 2; ++gg) {
        const int g = (F.wave >> 1) * 2 + gg, head = kvh * 8 + g; const size_t o = r * DM + kvh * 512 + g * 64 + F.lane;
        const float res = swa_row(Ks, Vs, t + 1, 0, bf2f(WSB(WS_QA)[o]), exp2f(-0.25f * (float)(head + 1)), sinks[head], F.lane);
        WSB(WS_BRA)[o] = (bf16)f2bf(res * bf2f(WSB(WS_SZA)[o]));
    }
    __syncthreads();
}
__device__ __forceinline__ void p2_mixers_scalar(Frame& F, const float* sC, const float* sn, const float* sm, const float* sk, const float* sv, const float* sinks) {
    constexpr int J_MP = 256, J_MS = J_MP + SB * MH * 16, J_AP = J_MS + NB * 32 * 4, J_AS = J_AP + SB * 4 * 2;
#ifndef REP2
#define REP2 0
#endif
    for (int rp_ = 0; rp_ < ((REP2 & 1) ? 2 : 1); ++rp_)
    for (int j = F.vcu; j < J_MP; j += F.G) { const int bh = j >> 4, vs = j & 15, b = bh >> 2, h = bh & 3;
#ifdef P2_ML
        ml::mlstm_job(F, bh, vs, F.out + O_CP + (size_t)bh * 512 * 512, F.out + O_NP + (size_t)bh * 512); (void)b; (void)h;
#else
        mlstm_scalar_job(F, b * SEQ, SEQ, h, vs, nullptr, nullptr, 0.f, F.out + O_CP + (size_t)bh * 512 * 512, F.out + O_NP + (size_t)bh * 512, F.out + O_MP + bh);
#endif
    }
    asm volatile("" ::: "memory");
#ifdef P2_ML
    for (int rp_ = 0; rp_ < ((REP2 & 2) ? 2 : 1); ++rp_)
    for (int j = F.vcu; j < SB * MH * 2; j += F.G) mlstm_sample_job(F, sC, sn, sm, j >> 3, (j >> 1) & 3, j & 1);
    asm volatile("" ::: "memory");
    for (int rp_ = 0; rp_ < ((REP2 & 4) ? 2 : 1); ++rp_)
    for (int j = F.vcu; j < NB * 16 * 4; j += F.G) at::swa_unit(F, sinks, j >> 6, (j >> 2) & 15, j & 3);
#else
    for (int j = J_MP + F.vcu; j < J_MS; j += F.G) { const int q = j - J_MP, bh = q >> 4, vs = q & 15, b = bh >> 2, h = bh & 3;
        mlstm_scalar_job(F, NTP + b * ST, ST, h, vs, sC + (size_t)bh * 512 * 512, sn + (size_t)bh * 512, sm[bh], F.out + O_CS + (size_t)bh * 512 * 512, F.out + O_NS + (size_t)bh * 512, F.out + O_MS + bh); }
    asm volatile("" ::: "memory");
    for (int j = J_MS + F.vcu; j < J_AP; j += F.G) { const int q = j - J_MS; swa_prompt_unit(F, sinks, q >> 7, (q >> 2) & 31, q & 3); }
#endif
    asm volatile("" ::: "memory");
    for (int rp_ = 0; rp_ < ((REP2 & 8) ? 2 : 1); ++rp_)
    for (int j = J_AP + F.vcu; j < J_AS; j += F.G) { const int q = j - J_AP; swa_sample_unit(F, sinks, sk, sv, q >> 3, (q >> 1) & 3, q & 1); }
}
__device__ __forceinline__ void p3_brm(Frame& F, const float* nw) {
    const int gw = F.vcu * NWAVES + F.wave, NGW = F.G * NWAVES, lane = F.lane;
    for (int r = gw; r < MPAD; r += NGW) {
        if (r >= NTOK) { ((v4u*)(WSB(WS_BRM) + (size_t)r * DM))[lane] = (v4u){0u, 0u, 0u, 0u}; ((v4u*)(WSB(WS_BRM) + (size_t)r * DM))[64 + lane] = (v4u){0u, 0u, 0u, 0u};
                         ((v4u*)(WSB(WS_BRM) + (size_t)r * DM))[128 + lane] = (v4u){0u, 0u, 0u, 0u}; ((v4u*)(WSB(WS_BRM) + (size_t)r * DM))[192 + lane] = (v4u){0u, 0u, 0u, 0u}; continue; }
        f32x4 a[4], b[4], w0[4], w1[4]; v4u g[4];
#pragma unroll
        for (int hh = 0; hh < 4; ++hh) { const size_t o = (size_t)r * DM + hh * 512 + lane * 8;
            a[hh] = *(const f32x4*)(WSF(WS_HM) + o); b[hh] = *(const f32x4*)(WSF(WS_HM) + o + 4); g[hh] = *(const v4u*)(WSB(WS_GM) + o);
            w0[hh] = *(const f32x4*)(nw + hh * 512 + lane * 8); w1[hh] = *(const f32x4*)(nw + hh * 512 + lane * 8 + 4); }
#pragma unroll
        for (int hh = 0; hh < 4; ++hh) { const size_t o = (size_t)r * DM + hh * 512 + lane * 8;
            const float mean = wave_sum((a[hh][0] + a[hh][1]) + (a[hh][2] + a[hh][3]) + (b[hh][0] + b[hh][1]) + (b[hh][2] + b[hh][3])) * (1.f / 512.f);
            const f32x4 da = a[hh] - mean, db = b[hh] - mean;
            const float var = wave_sum((da[0] * da[0] + da[1] * da[1]) + (da[2] * da[2] + da[3] * da[3]) + (db[0] * db[0] + db[1] * db[1]) + (db[2] * db[2] + db[3] * db[3])) * (1.f / 512.f);
            const float rstd = 1.0f / sqrtf(var + LN_EPS);
            v4u w;
            w.x = pk2(da[0] * rstd * w0[hh][0] * bflo(g[hh].x), da[1] * rstd * w0[hh][1] * bfhi(g[hh].x)); w.y = pk2(da[2] * rstd * w0[hh][2] * bflo(g[hh].y), da[3] * rstd * w0[hh][3] * bfhi(g[hh].y));
            w.z = pk2(db[0] * rstd * w1[hh][0] * bflo(g[hh].z), db[1] * rstd * w1[hh][1] * bfhi(g[hh].z)); w.w = pk2(db[2] * rstd * w1[hh][2] * bflo(g[hh].w), db[3] * rstd * w1[hh][3] * bfhi(g[hh].w));
            *(v4u*)(WSB(WS_BRM) + o) = w;
        }
    }
}
__device__ __forceinline__ void p6_ln(Frame& F, const float* lnw, const float* lnb) {
    const int gw = F.vcu * NWAVES + F.wave, NGW = F.G * NWAVES, lane = F.lane;
    for (int r = gw; r < NTOK; r += NGW) {
        f32x4* row = (f32x4*)(F.out + (size_t)r * DM) + lane;
        f32x4 v[8]; float s = 0.f;
#pragma unroll
        for (int j = 0; j < 8; ++j) { v[j] = row[64 * j]; s += (v[j][0] + v[j][1]) + (v[j][2] + v[j][3]); }
        const float mean = wave_sum(s) * (1.f / DM); float s2 = 0.f;
#pragma unroll
        for (int j = 0; j < 8; ++j) { v[j] = v[j] - mean; s2 += (v[j][0] * v[j][0] + v[j][1] * v[j][1]) + (v[j][2] * v[j][2] + v[j][3] * v[j][3]); }
        const float rstd = 1.0f / sqrtf(wave_sum(s2) * (1.f / DM) + LN_EPS);
#pragma unroll
        for (int j = 0; j < 8; ++j) { const f32x4 w = ((const f32x4*)lnw)[lane + 64 * j], bb = ((const f32x4*)lnb)[lane + 64 * j]; row[64 * j] = v[j] * rstd * w + bb; }
    }
}
template <int MODE>
__device__ __forceinline__ void skinny_unit(Frame& F, const bf16* A, const bf16* Bt, int u, const float* xs) {
    typedef short bf16x8 __attribute__((ext_vector_type(8)));
    const int lane = F.lane, l15 = lane & 15, q = lane >> 4, w = F.wave, rb = u >> 6, cb = u & 63;
    const bf16x8* ap = (const bf16x8*)(A + (size_t)(NTP + 32 * rb + l15) * DM + 256 * w + 8 * q);
    const bf16x8* bp = (const bf16x8*)(Bt + (size_t)(32 * cb + l15) * DM + 256 * w + 8 * q);
    f32x4 acc[2][2];
#pragma unroll
    for (int i = 0; i < 2; ++i)
#pragma unroll
        for (int j = 0; j < 2; ++j) acc[i][j] = (f32x4){0.f, 0.f, 0.f, 0.f};
#pragma unroll 4
    for (int ks = 0; ks < 8; ++ks) {
        const bf16x8 a0 = ap[4 * ks], a1 = ap[4 * ks + 16 * (DM / 8)], b0 = bp[4 * ks], b1 = bp[4 * ks + 16 * (DM / 8)];
        acc[0][0] = __builtin_amdgcn_mfma_f32_16x16x32_bf16(b0, a0, acc[0][0], 0, 0, 0); acc[0][1] = __builtin_amdgcn_mfma_f32_16x16x32_bf16(b0, a1, acc[0][1], 0, 0, 0);
        acc[1][0] = __builtin_amdgcn_mfma_f32_16x16x32_bf16(b1, a0, acc[1][0], 0, 0, 0); acc[1][1] = __builtin_amdgcn_mfma_f32_16x16x32_bf16(b1, a1, acc[1][1], 0, 0, 0);
    }
    LAS f32x4* RED = (LAS f32x4*)F.lds;
#pragma unroll
    for (int nt = 0; nt < 2; ++nt)
#pragma unroll
        for (int mt = 0; mt < 2; ++mt) RED[((w * 2 + nt) * 2 + mt) * 64 + lane] = acc[nt][mt];
    __syncthreads();
    if (F.tid < 256) {
        const int m = F.tid & 31, nq = F.tid >> 5, nt = nq >> 2, mt = m >> 4, src = 16 * (nq & 3) + (m & 15);
        f32x4 s = RED[(nt * 2 + mt) * 64 + src];
#pragma unroll
        for (int ww = 1; ww < 8; ++ww) s += RED[((ww * 2 + nt) * 2 + mt) * 64 + src];
        const int row = NTP + 32 * rb + m, col = 32 * cb + 4 * nq; const size_t off = (size_t)row * DM + col;
        if (MODE == 0) { const unsigned long long g = *(const unsigned long long*)(WSB(WS_SGA) + off); const unsigned g0 = (unsigned)g, g1 = (unsigned)(g >> 32);
            *(f32x4*)(WSF(WS_P) + off) = (f32x4){s[0] * bflo(g0), s[1] * bfhi(g0), s[2] * bflo(g1), s[3] * bfhi(g1)}; }
        else if (MODE == 1) { const unsigned long long g = *(const unsigned long long*)(WSB(WS_SGM) + off); const unsigned g0 = (unsigned)g, g1 = (unsigned)(g >> 32); const f32x4 p = *(const f32x4*)(WSF(WS_P) + off);
            const unsigned o0 = pk2(s[0] * bflo(g0) + p[0], s[1] * bfhi(g0) + p[1]), o1 = pk2(s[2] * bflo(g1) + p[2], s[3] * bfhi(g1) + p[3]);
            *(unsigned long long*)(WSB(WS_Y) + off) = (unsigned long long)o0 | ((unsigned long long)o1 << 32); }
        else { const f32x4 x = *(const f32x4*)(xs + (size_t)(row - NTP) * DM + col); *(f32x4*)(F.out + off) = x * DN_ALPHA + s; }
    }
    __syncthreads();
}
constexpr int N_LAUNCHES = MK_N_LAUNCHES;
constexpr int PER_PHASE = 7;
struct Args { const float* in[17]; float* out; unsigned char* ws; int ph_lo, ph_hi; };
__global__ void __launch_bounds__(NWAVES * 64, 2) hybrid_fwd(Args args) {
    extern __shared__ __attribute__((aligned(16))) unsigned char lds[];
    Frame F;
    F.lds = (LAS unsigned char*)lds; F.ldsg = lds;
    F.MISC = (volatile LAS unsigned*)(F.lds + MISC_OFF);
    F.tid = threadIdx.x; F.lane = F.tid & 63; F.wave = __builtin_amdgcn_readfirstlane(F.tid >> 6);
    F.G = gridDim.x; { const int bx = blockIdx.x; F.vcu = (F.G % 8 == 0) ? (bx % 8) * (F.G / 8) + bx / 8 : bx; }
    unsigned char* ws = args.ws;
    F.ctl = (gu32*)(ws + WS_CTL);
    F.ws = ws; F.out = args.out;
    for (int u = F.tid; u < (LDS_BYTES - LDSCTL_OFF) / 4; u += NWAVES * 64) ((LAS unsigned*)(F.lds + LDSCTL_OFF))[u] = 0u;
    __syncthreads();
    XcdBarrier bar; bar.bar = (unsigned*)(F.ctl + CW_BAR); bar.x = 0; bar.st = nullptr;
    if (N_LAUNCHES == 1) bar = xcd_barrier_post((unsigned*)(F.ctl + CW_BAR), F.MISC + 8);
    const int lo = args.ph_lo, hi = args.ph_hi;
#ifdef PSTAMP
    unsigned long long ts_a = 0, ts_b = 0;
#define STAMP(i) do { __builtin_amdgcn_sched_barrier(0); if ((i) == PSTAMP) ts_a = __builtin_amdgcn_s_memrealtime(); if ((i) == PSEND) ts_b = __builtin_amdgcn_s_memrealtime(); __builtin_amdgcn_sched_barrier(0); } while (0)
#else
#define STAMP(i)
#endif
#ifndef PHASE_MASK
#define PHASE_MASK 0x7f
#endif
#define IN(k) (((PHASE_MASK >> (k)) & 1) && lo <= (k) && (k) < hi)
#ifndef REPEAT_MASK
#define REPEAT_MASK 0
#endif
#define REP(k) for (int rep_ = 0; rep_ < (((REPEAT_MASK >> (k)) & 1) ? 2 : 1); ++rep_)
#define SEAM(k) do { STAMP(2 * (k) + 1 + ((k) >= 2 ? 2 : 0)); if (IN(k) && IN((k) + 1)) xcd_barrier(bar); STAMP(2 * (k) + 2 + ((k) >= 2 ? 2 : 0)); } while (0)
    STAMP(0);
    if (IN(0)) { REP(0) p0_prologue(F, args.in[0], args.in[1], args.in[7], args.in[12], args.in[13], args.in[14], args.in[8], args.in[9], args.in[5], args.in[6]); SEAM(0); }
    if (IN(1)) { REP(1) {
#ifdef P1STAT
        const unsigned long long p1t0_ = __builtin_amdgcn_s_memrealtime();
#endif
#ifdef P2_ML
        if ((int)blockIdx.x >= F.G - 16) { if (F.wave == 0) ml::gate_scan(F, (int)blockIdx.x - (F.G - 16), F.lane); __syncthreads(); }
#endif
        pg8::Gemm g{WSB(WS_XB), WSB(WS_WIN), MPAD, NIN, DM}; pg8::StaticOrder S; S.init(MPAD, NIN, F.G, (int)blockIdx.x);
        pg8::EpiInProj E{F.ws, F.out};
        pg8::gemm_phase<pg8::EpiInProj, pg8::StaticOrder, true, true>(F.lds + RING_OFF, g, S, E);
#ifdef P1STAT
        { const unsigned long long t1_ = __builtin_amdgcn_s_memrealtime(); const unsigned d_ = (unsigned)(t1_ - p1t0_);
          if (F.tid == 0) { const bool ten = S.nwg > 9 * F.G + (int)blockIdx.x;
            if (ten) { __hip_atomic_fetch_max((unsigned*)(F.ctl + 2048), d_, __ATOMIC_RELAXED, __HIP_MEMORY_SCOPE_AGENT); __hip_atomic_fetch_min((unsigned*)(F.ctl + 2112), 0xffffffffu - d_, __ATOMIC_RELAXED, __HIP_MEMORY_SCOPE_AGENT);
                       __hip_atomic_fetch_max((unsigned*)(F.ctl + 2176), (d_ << 8 >> 8 << 8) | 0u, __ATOMIC_RELAXED, __HIP_MEMORY_SCOPE_AGENT); __hip_atomic_fetch_max((unsigned long long*)(F.ctl + 2240), ((unsigned long long)d_ << 16) | blockIdx.x, __ATOMIC_RELAXED, __HIP_MEMORY_SCOPE_AGENT); }
            else __hip_atomic_fetch_max((unsigned*)(F.ctl + 2304), d_, __ATOMIC_RELAXED, __HIP_MEMORY_SCOPE_AGENT); } }
#endif
        }
        SEAM(1);
    }
    if (IN(2)) {
#ifdef P2_ML
        for (int j = F.vcu; j < 512; j += F.G) ml::sd_task(F, j >> 5, j & 31);
        STAMP(5);
        xcd_barrier(bar);
        STAMP(6);
#endif
        REP(2) p2_mixers_scalar(F, args.in[2], args.in[3], args.in[4], args.in[5], args.in[6], args.in[11]); SEAM(2); }
    if (IN(3)) { REP(3) {
        p3_brm(F, args.in[10]);
        pg8::Gemm g{WSB(WS_BRA), WSB(WS_WPA), NTP, DM, DM}; pg8::StaticOrder S; S.init(NTP, DM, F.G, (int)blockIdx.x);
        pg8::EpiPA E{WSB(WS_SGA), WSF(WS_P)};
        pg8::gemm_phase<pg8::EpiPA, pg8::StaticOrder, true, true>(F.lds + RING_OFF, g, S, E);
        for (int u = F.vcu; u < 256; u += F.G) skinny_unit<0>(F, WSB(WS_BRA), WSB(WS_WPA), u, nullptr); }
        SEAM(3);
    }
    if (IN(4)) { REP(4) {
        pg8::Gemm g{WSB(WS_BRM), WSB(WS_WPM), NTP, DM, DM}; pg8::StaticOrder S; S.init(NTP, DM, F.G, (int)blockIdx.x);
        pg8::EpiY E{WSB(WS_SGM), WSF(WS_P), WSB(WS_Y)};
        pg8::gemm_phase<pg8::EpiY, pg8::StaticOrder, true, true>(F.lds + RING_OFF, g, S, E);
        for (int u = F.vcu; u < 256; u += F.G) skinny_unit<1>(F, WSB(WS_BRM), WSB(WS_WPM), u, nullptr); }
        SEAM(4);
    }
    if (IN(5)) { REP(5) {
        pg8::Gemm g{WSB(WS_Y), WSB(WS_WOUT), NTP, DM, DM}; pg8::StaticOrder S; S.init(NTP, DM, F.G, (int)blockIdx.x);
        pg8::EpiOut E{args.in[0], F.out, DN_ALPHA};
        pg8::gemm_phase<pg8::EpiOut, pg8::StaticOrder, true, true>(F.lds + RING_OFF, g, S, E);
        for (int u = F.vcu; u < 256; u += F.G) skinny_unit<2>(F, WSB(WS_Y), WSB(WS_WOUT), u, args.in[1]); }
        SEAM(5);
    }
    if (IN(6)) p6_ln(F, args.in[15], args.in[16]);
    STAMP(15);
#ifdef P1STAT
    if (blockIdx.x == 0 && F.tid == 0) { float v_ = 0.f;
        if (P1STAT == 0) v_ = 16.f * (float)(__hip_atomic_load((unsigned*)(F.ctl + 2048), __ATOMIC_RELAXED, __HIP_MEMORY_SCOPE_AGENT) / 1600u);
        if (P1STAT == 1) v_ = 0.01f * (float)(0xffffffffu - __hip_atomic_load((unsigned*)(F.ctl + 2112), __ATOMIC_RELAXED, __HIP_MEMORY_SCOPE_AGENT));
        if (P1STAT == 2) v_ = (float)(__hip_atomic_load((unsigned long long*)(F.ctl + 2240), __ATOMIC_RELAXED, __HIP_MEMORY_SCOPE_AGENT) & 0xffffull);
        if (P1STAT == 3) v_ = 16.f * (float)(__hip_atomic_load((unsigned*)(F.ctl + 2304), __ATOMIC_RELAXED, __HIP_MEMORY_SCOPE_AGENT) / 1600u);
        F.out[O_MP] += v_; }
#endif
#ifdef PSTAMP
    if (blockIdx.x == PSBLOCK && F.tid == 0) F.out[O_MP] += 32.0f * (float)((unsigned)(ts_b - ts_a) / 3200u);
#endif
#undef IN
#undef REP
#undef SEAM
}

extern "C" void kernel_launch(void* const* d_in, const int* in_sizes, int n_in, void* d_out, int out_size, void* d_ws, size_t ws_size, hipStream_t stream) {
    static int grid = 0;
    if (grid == 0) {
        if (n_in != 17 || out_size != (int)O_END || ws_size < WS_END) { fprintf(stderr, "kernel_launch: unexpected problem (n_in %d, out %d, ws %zu); nothing launched\n", n_in, out_size, ws_size); grid = -1; return; }
        int dev = 0, cus = 0, per_cu = 0;
        if (hipGetDevice(&dev) != hipSuccess || hipDeviceGetAttribute(&cus, hipDeviceAttributeMultiprocessorCount, dev) != hipSuccess) { fprintf(stderr, "kernel_launch: device query failed\n"); grid = -1; return; }
        if (hipFuncSetAttribute((const void*)hybrid_fwd, hipFuncAttributeMaxDynamicSharedMemorySize, LDS_BYTES) != hipSuccess) { fprintf(stderr, "kernel_launch: hipFuncSetAttribute failed\n"); grid = -1; return; }
        if (hipOccupancyMaxActiveBlocksPerMultiprocessor(&per_cu, (const void*)hybrid_fwd, NWAVES * 64, LDS_BYTES) != hipSuccess || per_cu < 1) { fprintf(stderr, "kernel_launch: occupancy query says %d blocks per CU\n", per_cu); (void)hipGetLastError(); grid = -1; return; }
        grid = cus;
    }
    if (grid < 0) return;
    (void)hipMemsetAsync((char*)d_ws + WS_CTL, 0, CTL_ZERO_BYTES, stream);
    Args a{};
    for (int i = 0; i < 17; ++i) a.in[i] = (const float*)d_in[i];
    a.out = (float*)d_out; a.ws = (unsigned char*)d_ws;
    if (N_LAUNCHES == 1) { a.ph_lo = 0; a.ph_hi = PER_PHASE; hipLaunchKernelGGL(hybrid_fwd, dim3(grid), dim3(NWAVES * 64), LDS_BYTES, stream, a); }
    else for (int li = 0; li < PER_PHASE; ++li) { a.ph_lo = li; a.ph_hi = li + 1; hipLaunchKernelGGL(hybrid_fwd, dim3(grid), dim3(NWAVES * 64), LDS_BYTES, stream, a); }
    const hipError_t le = hipPeekAtLastError();
    if (le != hipSuccess) fprintf(stderr, "kernel_launch: launch failed: %s\n", hipGetErrorName(le));
}
```
